# Optimizing an MI355X kernel written in HIP

```python
import math
import jax, jax.numpy as jnp
from jax import lax
import numpy as np

D_MODEL = 1024
BATCH = 16
SEQ = 4096
DEPTH = 1

POOL_GROUPS = 4
POOL_WINDOWS = (2, 4, 8, 16)
POOL_WIDTH = D_MODEL // 2
POOL_GROUP_DIM = POOL_WIDTH // POOL_GROUPS
N_HEADS = 8
QK_NOPE_DIM = 128
QK_ROPE_DIM = 64
V_DIM = 128
Q_LORA = D_MODEL // 4
KV_LORA = D_MODEL // 8
QK_DIM = QK_NOPE_DIM + QK_ROPE_DIM
ROPE_THETA = 10000.0
Q_BLOCK = 128
D_FF = 4 * D_MODEL
EPS = 1e-6
IN_COLS = POOL_WIDTH + Q_LORA + KV_LORA + QK_ROPE_DIM + 2 * D_MODEL
SPLITS = tuple(np.cumsum([POOL_WIDTH, Q_LORA, KV_LORA, QK_ROPE_DIM, D_MODEL]).tolist())

kernel_name = "hybrid_pool_mla_gated_block"


def rmsnorm(x, g):
    xf = x.astype(jnp.float32)
    xf = xf * lax.rsqrt(jnp.mean(xf * xf, axis=-1, keepdims=True) + EPS)
    return (xf * g.astype(jnp.float32)).astype(x.dtype)


def rope(x, cos, sin):
    x1, x2 = jnp.split(x, 2, axis=-1)
    return jnp.concatenate([x1 * cos - x2 * sin, x2 * cos + x1 * sin], axis=-1)


def causal_window_mean(u, w):
    s = u.shape[1]
    cs = jnp.cumsum(u, axis=1)
    lag = jnp.pad(cs[:, : s - w], ((0, 0), (w, 0), (0, 0)))
    count = jnp.minimum(jnp.arange(1, s + 1), w).astype(jnp.float32)
    return (cs - lag) / count[None, :, None]


def pool_mixer(u, pool_w, pool_scale, w_proj):
    b, s, _ = u.shape
    ug = u.reshape(b, s, POOL_GROUPS, POOL_GROUP_DIM)
    pooled = []
    for g, w in enumerate(POOL_WINDOWS):
        ui = ug[:, :, g].astype(jnp.float32)
        pooled.append(causal_window_mean(ui, w) - ui)
    pooled = jnp.stack(pooled, axis=2).astype(u.dtype)
    mixed = jnp.einsum('bsgc,gcd->bsgd', pooled, pool_w).reshape(b, s, POOL_WIDTH)
    return (mixed * pool_scale) @ w_proj


def mla_mixer(c_q, c_kv, k_rope_in, cos, sin, g_q, w_uq, g_kv, w_ukv, w_proj):
    b, s, _ = c_q.shape
    q = (rmsnorm(c_q, g_q) @ w_uq).reshape(b, s, N_HEADS, QK_DIM)
    q_nope, q_rope = q[..., :QK_NOPE_DIM], q[..., QK_NOPE_DIM:]
    q_rope = rope(q_rope, cos[:, :, None, :], sin[:, :, None, :])
    kv = (rmsnorm(c_kv, g_kv) @ w_ukv).reshape(b, s, N_HEADS, QK_NOPE_DIM + V_DIM)
    k_nope, v = kv[..., :QK_NOPE_DIM], kv[..., QK_NOPE_DIM:]
    k_rope = rope(k_rope_in, cos, sin)
    scale = 1.0 / math.sqrt(QK_DIM)
    k_idx = jnp.arange(s)

    def block(i):
        start = i * Q_BLOCK
        qn = lax.dynamic_slice_in_dim(q_nope, start, Q_BLOCK, axis=1)
        qr = lax.dynamic_slice_in_dim(q_rope, start, Q_BLOCK, axis=1)
        sc = (jnp.einsum('bqhd,bkhd->bhqk', qn, k_nope)
              + jnp.einsum('bqhd,bkd->bhqk', qr, k_rope)).astype(jnp.float32) * scale
        q_idx = start + jnp.arange(Q_BLOCK)
        mask = k_idx[None, :] <= q_idx[:, None]
        p = jax.nn.softmax(jnp.where(mask, sc, -jnp.inf), axis=-1).astype(v.dtype)
        return jnp.einsum('bhqk,bkhd->bqhd', p, v)

    o = lax.map(block, jnp.arange(s // Q_BLOCK))
    o = jnp.transpose(o, (1, 0, 2, 3, 4)).reshape(b, s, N_HEADS * V_DIM)
    return o @ w_proj


def setup_inputs(seed: int = 0) -> dict:
    key = jax.random.key(seed)
    ks = jax.random.split(key, 24)
    L, D = DEPTH, D_MODEL

    def w(k, shape, fan_in):
        return jax.random.normal(k, shape, jnp.float32) * fan_in ** -0.5

    def gain(k, shape):
        return 1.0 + 0.01 * jax.random.normal(k, shape, jnp.float32)

    x = jax.random.normal(ks[0], (BATCH, SEQ, D), jnp.float32)
    offsets = jax.random.randint(ks[1], (BATCH, 1), 0, 1024, jnp.int32)
    positions = (jnp.arange(SEQ, dtype=jnp.int32)[None, :] + offsets).astype(jnp.int32)
    return {
        "x": x,
        "positions": positions,
        "g_mix": gain(ks[2], (L, D)),
        "w_in": w(ks[3], (L, D, IN_COLS), D),
        "b_gate": 0.01 * jax.random.normal(ks[4], (L, 2 * D), jnp.float32),
        "pool_w": w(ks[5], (L, POOL_GROUPS, POOL_GROUP_DIM, POOL_GROUP_DIM), POOL_GROUP_DIM),
        "pool_scale": gain(ks[6], (L, POOL_WIDTH)),
        "w_pool_proj": w(ks[7], (L, POOL_WIDTH, D), POOL_WIDTH),
        "g_q": gain(ks[8], (L, Q_LORA)),
        "w_uq": w(ks[9], (L, Q_LORA, N_HEADS * QK_DIM), Q_LORA),
        "g_kv": gain(ks[10], (L, KV_LORA)),
        "w_ukv": w(ks[11], (L, KV_LORA, N_HEADS * (QK_NOPE_DIM + V_DIM)), KV_LORA),
        "w_attn_proj": w(ks[12], (L, N_HEADS * V_DIM, D), N_HEADS * V_DIM),
        "w_out": w(ks[13], (L, D, D), D),
        "g_mlp": gain(ks[14], (L, D)),
        "w_mlp_in": w(ks[15], (L, D, D_FF), D),
        "w_mlp_out": w(ks[16], (L, D_FF, D), D_FF),
        "g_final": gain(ks[17], (D,)),
    }


def reference(x, positions, g_mix, w_in, b_gate, pool_w, pool_scale, w_pool_proj,
              g_q, w_uq, g_kv, w_ukv, w_attn_proj, w_out, g_mlp, w_mlp_in,
              w_mlp_out, g_final):
    half = QK_ROPE_DIM // 2
    inv_freq = ROPE_THETA ** (-jnp.arange(half, dtype=jnp.float32) / half)
    ang = positions.astype(jnp.float32)[..., None] * inv_freq
    cos = jnp.cos(ang).astype(x.dtype)
    sin = jnp.sin(ang).astype(x.dtype)

    for l in range(DEPTH):
        h = rmsnorm(x, g_mix[l])
        z = h @ w_in[l]
        u_pool, c_q, c_kv, k_rope_in, gate_a, gate_b = jnp.split(z, SPLITS, axis=-1)
        gate_a = jax.nn.sigmoid(gate_a + b_gate[l, :D_MODEL])
        gate_b = jax.nn.sigmoid(gate_b + b_gate[l, D_MODEL:])
        a = pool_mixer(u_pool, pool_w[l], pool_scale[l], w_pool_proj[l])
        bm = mla_mixer(c_q, c_kv, k_rope_in, cos, sin, g_q[l], w_uq[l], g_kv[l],
                       w_ukv[l], w_attn_proj[l])
        x = x + (gate_a * a + gate_b * bm) @ w_out[l]
        hm = rmsnorm(x, g_mlp[l])
        x = x + jnp.square(jax.nn.relu(hm @ w_mlp_in[l])) @ w_mlp_out[l]

    return rmsnorm(x, g_final)
```

```cpp
#include <hip/hip_runtime.h>
#include <hip/hip_bf16.h>
#include <hip/hip_cooperative_groups.h>
#include <cstdio>
#include <cstdint>
#include <cmath>
namespace cg = cooperative_groups;
namespace pg8 {
#define PG8_LAS __attribute__((address_space(3)))
typedef unsigned short bf16_t;
typedef short bf16x8 __attribute__((ext_vector_type(8)));
typedef float f32x4 __attribute__((ext_vector_type(4)));
typedef unsigned u32x4 __attribute__((ext_vector_type(4)));
constexpr int BM = 256, BK = 64, HALF = 128, HTB = HALF * BK * 2  , STAGE_BYTES = 8 * HTB, NXCD = 8, WGM = 8;

__host__ __device__ __forceinline__ int lds_byte(int r, int c) { const int st = (r >> 4) * 2 + (c >> 5), rr = r & 15, cc = c & 31, ob = rr * 64 + cc * 2; return st * 1024 + (ob ^ (((ob >> 9) & 1) << 5)); }
__host__ __device__ __forceinline__ void stage_rc(int b, int& R, int& C) { const int st = b / 1024, sb = b % 1024, swz = sb ^ (((sb >> 9) & 1) << 5); R = (st >> 1) * 16 + swz / 64; C = (st & 1) * 32 + (swz % 64) / 2; }
__host__ __device__ __forceinline__ int perm32(int rho) { const int n = rho >> 4, i = rho & 15; return 8 * (i >> 2) + 4 * n + (i & 3); }

struct Unit { int pm, pn; };
struct Gemm { const bf16_t* A; const bf16_t* Bt; int M, N, K; };

struct StaticOrder {
    int nM, nN, nwg, G, c;
    __host__ __device__ void init(int M, int N, int G_, int c_) { nM = M / BM; nN = N / BM; nwg = nM * nN; G = G_; c = c_; }
    __host__ __device__ bool next(int i, Unit& u) const {
        const long L = (long)i * G + c; if (L >= nwg) return false;
        int wgid = (int)L; { const int q = nwg / NXCD, r = nwg % NXCD, xcd = wgid % NXCD, off = wgid / NXCD; wgid = (xcd < r ? xcd * (q + 1) : r * (q + 1) + (xcd - r) * q) + off; }
        const int nig = WGM * nN, gid = wgid / nig, fm = gid * WGM, gsz = (nM - fm) < WGM ? (nM - fm) : WGM;
        u.pm = fm + ((wgid % nig) % gsz); u.pn = (wgid % nig) / gsz; return true;
    }
    __device__ __forceinline__ void a_ready(const Unit&) const {}
    __device__ __forceinline__ void done(const Unit&) const {}
};

typedef float f32x2_cv __attribute__((ext_vector_type(2))); typedef __bf16 bf16x2_cv __attribute__((ext_vector_type(2)));
__device__ __forceinline__ unsigned cvt_pk_bf16(float lo, float hi) { f32x2_cv v = {lo, hi}; bf16x2_cv b = __builtin_convertvector(v, bf16x2_cv); return __builtin_bit_cast(unsigned, b); }
typedef float f32x2 __attribute__((ext_vector_type(2)));
constexpr float RMS_EPS = 1e-6f;
__device__ __forceinline__ u32x4 pack8(f32x4 a, f32x4 b) { u32x4 w; w.x = cvt_pk_bf16(a[0], a[1]); w.y = cvt_pk_bf16(a[2], a[3]); w.z = cvt_pk_bf16(b[0], b[1]); w.w = cvt_pk_bf16(b[2], b[3]); return w; }
__device__ __forceinline__ void unpack8(u32x4 w, f32x4& a, f32x4& b) {
    a[0] = __uint_as_float(w.x << 16); a[1] = __uint_as_float(w.x & 0xffff0000u); a[2] = __uint_as_float(w.y << 16); a[3] = __uint_as_float(w.y & 0xffff0000u);
    b[0] = __uint_as_float(w.z << 16); b[1] = __uint_as_float(w.z & 0xffff0000u); b[2] = __uint_as_float(w.w << 16); b[3] = __uint_as_float(w.w & 0xffff0000u); }
__device__ __forceinline__ float sumsq4(f32x4 v) { return (v[0] * v[0] + v[1] * v[1]) + (v[2] * v[2] + v[3] * v[3]); }
__device__ __forceinline__ float sigm(float v) { return __builtin_amdgcn_rcpf(1.0f + __builtin_amdgcn_exp2f(-1.4426950408889634f * v)); }
__device__ __forceinline__ f32x4 sigm4(f32x4 v) { return (f32x4){sigm(v[0]), sigm(v[1]), sigm(v[2]), sigm(v[3])}; }
typedef unsigned u32x2 __attribute__((ext_vector_type(2)));
__device__ __forceinline__ void rope_store(f32x4 v0, f32x4 v1, const float* cs, const float* sn, bf16_t* dst) {
    const f32x4 c = *(const f32x4*)cs, s = *(const f32x4*)sn;
    const f32x4 x1 = (f32x4){v0[0], v0[2], v1[0], v1[2]}, x2 = (f32x4){v0[1], v0[3], v1[1], v1[3]};
    const f32x4 o1 = x1 * c - x2 * s, o2 = x2 * c + x1 * s;
    u32x2 a, b; a.x = cvt_pk_bf16(o1[0], o1[1]); a.y = cvt_pk_bf16(o1[2], o1[3]); b.x = cvt_pk_bf16(o2[0], o2[1]); b.y = cvt_pk_bf16(o2[2], o2[3]);
    *(u32x2*)dst = a; *(u32x2*)(dst + 32) = b;
}
__device__ __forceinline__ void rope_store_r(f32x4 v0, f32x4 v1, f32x4 c, f32x4 sn, bf16_t* dst) {
    const f32x4 x1 = (f32x4){v0[0], v0[2], v1[0], v1[2]}, x2 = (f32x4){v0[1], v0[3], v1[1], v1[3]};
    const f32x4 o1 = x1 * c - x2 * sn, o2 = x2 * c + x1 * sn;
    u32x2 a, b; a.x = cvt_pk_bf16(o1[0], o1[1]); a.y = cvt_pk_bf16(o1[2], o1[3]); b.x = cvt_pk_bf16(o2[0], o2[1]); b.y = cvt_pk_bf16(o2[2], o2[3]);
    *(u32x2*)dst = a; *(u32x2*)(dst + 32) = b;
}
#define EPI_ROWS_F(...) _Pragma("unroll") for (int ai = 0; ai < 2; ++ai) _Pragma("unroll") for (int m = 0; m < 4; ++m) { const int row = row0 + ai * HALF + m * 16; __VA_ARGS__ if (m & 1) asm volatile("" ::: "memory"); }
#define EPI_ROWS(...) _Pragma("unroll") for (int ai = 0; ai < 2; ++ai) _Pragma("unroll") for (int m = 0; m < 4; ++m) { const int row = row0 + ai * HALF + m * 16; __VA_ARGS__ }

struct EpiZ {
    static constexpr bool PERM = true, AFTER_DRAIN = false;
    bf16_t *U, *CQ, *CKV, *KR, *GA, *GB; float *ssq_q, *ssq_kv; const float *bgate, *cosT, *sinT;
    __device__ __forceinline__ void operator()(const f32x4 (&acc)[2][2][4][2], const Unit& u, int wr, int wc, int fr, int fq) const {
        const int row0 = u.pm * BM + wr * 64 + fr, pn = u.pn, cl = wc * 32 + 8 * fq;
        if (pn < 2) {
            EPI_ROWS( _Pragma("unroll") for (int bj = 0; bj < 2; ++bj) *(u32x4*)(U + (size_t)row * 512 + pn * 256 + bj * HALF + cl) = pack8(acc[ai][bj][m][0], acc[ai][bj][m][1]); )
        } else if (pn == 2) {
            EPI_ROWS( float s = 0.f;
                _Pragma("unroll") for (int bj = 0; bj < 2; ++bj) { *(u32x4*)(CQ + (size_t)row * 256 + bj * HALF + cl) = pack8(acc[ai][bj][m][0], acc[ai][bj][m][1]); s += sumsq4(acc[ai][bj][m][0]) + sumsq4(acc[ai][bj][m][1]); }
                s += __shfl_xor(s, 16); s += __shfl_xor(s, 32); if (fq == 0) atomicAdd(ssq_q + row, s); )
        } else if (pn == 3) {
            const int i0 = 16 * (wc & 1) + 4 * fq;
#pragma unroll
            for (int ai = 0; ai < 2; ++ai) {
                f32x4 cs[4], sn[4];
                if (wc < 2) {
#pragma unroll
                    for (int m = 0; m < 4; ++m) { const size_t o_ = (size_t)(row0 + ai * HALF + m * 16) * 32 + i0; cs[m] = *(const f32x4*)(cosT + o_); sn[m] = *(const f32x4*)(sinT + o_); } }
                __builtin_amdgcn_sched_barrier(0);
#pragma unroll
                for (int m = 0; m < 4; ++m) { const int row = row0 + ai * HALF + m * 16;
                    float s = sumsq4(acc[ai][0][m][0]) + sumsq4(acc[ai][0][m][1]);
                    *(u32x4*)(CKV + (size_t)row * 128 + cl) = pack8(acc[ai][0][m][0], acc[ai][0][m][1]);
                    s += __shfl_xor(s, 16); s += __shfl_xor(s, 32); if (fq == 0) atomicAdd(ssq_kv + row, s);
                    if (wc < 2) rope_store_r(acc[ai][1][m][0], acc[ai][1][m][1], cs[m], sn[m], KR + (size_t)row * 64 + i0); }
                __builtin_amdgcn_sched_barrier(0);
            }
        } else {
            bf16_t* G = pn < 8 ? GA : GB; const int gc0 = (pn < 8 ? pn - 4 : pn - 8) * 256, bc0 = (pn - 4) * 256;
            f32x4 bv[2][2];
#pragma unroll
            for (int bj = 0; bj < 2; ++bj)
#pragma unroll
                for (int n = 0; n < 2; ++n) bv[bj][n] = *(const f32x4*)(bgate + bc0 + bj * HALF + cl + 4 * n);
            EPI_ROWS( _Pragma("unroll") for (int bj = 0; bj < 2; ++bj)
                *(u32x4*)(G + (size_t)row * 1024 + gc0 + bj * HALF + cl) = pack8(sigm4(acc[ai][bj][m][0] + bv[bj][0]), sigm4(acc[ai][bj][m][1] + bv[bj][1])); )
        }
    }
};
struct EpiQ {
    static constexpr bool PERM = true, AFTER_DRAIN = false;
    bf16_t* Q; const float* ssq_q; const float *cosT, *sinT;
    __device__ __forceinline__ void operator()(const f32x4 (&acc)[2][2][4][2], const Unit& u, int wr, int wc, int fr, int fq) const {
        const int row0 = u.pm * BM + wr * 64 + fr, pn = u.pn, cl = wc * 32 + 8 * fq;
        float rs[2][4];
#pragma unroll
        for (int ai = 0; ai < 2; ++ai)
#pragma unroll
            for (int m = 0; m < 4; ++m) rs[ai][m] = ssq_q[row0 + ai * HALF + m * 16];
        if (pn < 4) {
            __builtin_amdgcn_sched_barrier(0);
            EPI_ROWS( const float r_ = __builtin_amdgcn_rsqf(rs[ai][m] * (1.0f / 256.0f) + RMS_EPS);
                _Pragma("unroll") for (int bj = 0; bj < 2; ++bj) *(u32x4*)(Q + (size_t)row * 1536 + (2 * pn + bj) * 192 + cl) = pack8(acc[ai][bj][m][0] * r_, acc[ai][bj][m][1] * r_); )
        } else {
            const int i0 = 16 * (wc & 1) + 4 * fq;
#pragma unroll
            for (int ai = 0; ai < 2; ++ai) {
                f32x4 cs[4], sn[4];
#pragma unroll
                for (int m = 0; m < 4; ++m) { const size_t o_ = (size_t)(row0 + ai * HALF + m * 16) * 32 + i0; cs[m] = *(const f32x4*)(cosT + o_); sn[m] = *(const f32x4*)(sinT + o_); }
                __builtin_amdgcn_sched_barrier(0);
#pragma unroll
                for (int m = 0; m < 4; ++m) { const int row = row0 + ai * HALF + m * 16; const float r_ = __builtin_amdgcn_rsqf(rs[ai][m] * (1.0f / 256.0f) + RMS_EPS);
#pragma unroll
                    for (int bj = 0; bj < 2; ++bj) { const int h = 4 * (pn - 4) + 2 * bj + (wc >> 1);
                        rope_store_r(acc[ai][bj][m][0] * r_, acc[ai][bj][m][1] * r_, cs[m], sn[m], Q + (size_t)row * 1536 + h * 192 + 128 + i0); } }
                __builtin_amdgcn_sched_barrier(0);
            }
        }
    }
};
struct EpiKV {
    static constexpr bool PERM = true, AFTER_DRAIN = false;
    bf16_t *KN, *V; const float* ssq_kv;
    __device__ __forceinline__ void operator()(const f32x4 (&acc)[2][2][4][2], const Unit& u, int wr, int wc, int fr, int fq) const {
        const int row0 = u.pm * BM + wr * 64 + fr, cl = u.pn * 128 + wc * 32 + 8 * fq;
        EPI_ROWS_F( const float rs = __builtin_amdgcn_rsqf(ssq_kv[row] * (1.0f / 128.0f) + RMS_EPS);
            *(u32x4*)(KN + (size_t)row * 1024 + cl) = pack8(acc[ai][0][m][0] * rs, acc[ai][0][m][1] * rs);
            *(u32x4*)(V + (size_t)row * 1024 + cl) = pack8(acc[ai][1][m][0] * rs, acc[ai][1][m][1] * rs); )
    }
};
template <int MODE> struct EpiGate {
    static constexpr bool PERM = true, AFTER_DRAIN = false;
    bf16_t* Y; const bf16_t* G2;
    __device__ __forceinline__ void operator()(const f32x4 (&acc)[2][2][4][2], const Unit& u, int wr, int wc, int fr, int fq) const {
        const int row0 = u.pm * BM + wr * 64 + fr, c0 = u.pn * 256 + wc * 32 + 8 * fq;
        if constexpr (MODE == 0) {
            u32x4 yv[2][4][2];
#pragma unroll
            for (int ai = 0; ai < 2; ++ai)
#pragma unroll
                for (int m = 0; m < 4; ++m)
#pragma unroll
                    for (int bj = 0; bj < 2; ++bj) yv[ai][m][bj] = *(const u32x4*)(Y + (size_t)(row0 + ai * HALF + m * 16) * 1024 + c0 + bj * HALF);
            __builtin_amdgcn_sched_barrier(0);
#pragma unroll
            for (int ai = 0; ai < 2; ++ai)
#pragma unroll
                for (int m = 0; m < 4; ++m)
#pragma unroll
                    for (int bj = 0; bj < 2; ++bj) { f32x4 a, b; unpack8(yv[ai][m][bj], a, b);
                        *(u32x4*)(Y + (size_t)(row0 + ai * HALF + m * 16) * 1024 + c0 + bj * HALF) = pack8(a * acc[ai][bj][m][0], b * acc[ai][bj][m][1]); }
        } else {
#pragma unroll
            for (int ai = 0; ai < 2; ++ai) {
                u32x4 yv[4][2], gv[4][2];
#pragma unroll
                for (int m = 0; m < 4; ++m)
#pragma unroll
                    for (int bj = 0; bj < 2; ++bj) { const size_t off = (size_t)(row0 + ai * HALF + m * 16) * 1024 + c0 + bj * HALF; yv[m][bj] = *(const u32x4*)(Y + off); gv[m][bj] = *(const u32x4*)(G2 + off); }
                __builtin_amdgcn_sched_barrier(0);
#pragma unroll
                for (int m = 0; m < 4; ++m)
#pragma unroll
                    for (int bj = 0; bj < 2; ++bj) { const size_t off = (size_t)(row0 + ai * HALF + m * 16) * 1024 + c0 + bj * HALF;
                        f32x4 a, b, g0, g1; unpack8(yv[m][bj], a, b); unpack8(gv[m][bj], g0, g1);
                        *(u32x4*)(Y + off) = pack8(a + g0 * acc[ai][bj][m][0], b + g1 * acc[ai][bj][m][1]); }
                __builtin_amdgcn_sched_barrier(0);
            }
        }
    }
};
template <bool BF, bool DN = false> struct EpiRes {
    static constexpr bool PERM = true, AFTER_DRAIN = false;
    const void* base; bf16_t* XB; float* ssq; const float* rsq; const float* rms0; const float* gdn;
    __device__ __forceinline__ void operator()(const f32x4 (&acc)[2][2][4][2], const Unit& u, int wr, int wc, int fr, int fq) const {
        const int row0 = u.pm * BM + wr * 64 + fr, c0 = u.pn * 256 + wc * 32 + 8 * fq;
        f32x4 gi[2][2];
        if (DN) {
#pragma unroll
            for (int bj = 0; bj < 2; ++bj)
#pragma unroll
                for (int n = 0; n < 2; ++n) { const f32x4 g = *(const f32x4*)(gdn + c0 + bj * HALF + 4 * n); gi[bj][n] = (f32x4){__builtin_amdgcn_rcpf(g[0]), __builtin_amdgcn_rcpf(g[1]), __builtin_amdgcn_rcpf(g[2]), __builtin_amdgcn_rcpf(g[3])}; } }
#pragma unroll
        for (int ai = 0; ai < 2; ++ai) {
            f32x4 xa[4][2], xb[4][2]; u32x4 xh[4][2]; float rq[4], rm[4];
#pragma unroll
            for (int m = 0; m < 4; ++m) { rq[m] = rsq ? rsq[row0 + ai * HALF + m * 16] : 0.f; rm[m] = DN ? rms0[row0 + ai * HALF + m * 16] : 1.f;
#pragma unroll
                for (int bj = 0; bj < 2; ++bj) { const size_t off = (size_t)(row0 + ai * HALF + m * 16) * 1024 + c0 + bj * HALF;
                    if (BF) xh[m][bj] = *(const u32x4*)((const bf16_t*)base + off); else { xa[m][bj] = *(const f32x4*)((const float*)base + off); xb[m][bj] = *(const f32x4*)((const float*)base + off + 4); } } }
            __builtin_amdgcn_sched_barrier(0);
#pragma unroll
            for (int m = 0; m < 4; ++m) { const int row = row0 + ai * HALF + m * 16; float s = 0.f; const float r2 = rsq ? __builtin_amdgcn_rcpf(rq[m] * (1.0f / 1024.0f) + RMS_EPS) : 1.0f;
#pragma unroll
                for (int bj = 0; bj < 2; ++bj) { const size_t off = (size_t)row * 1024 + c0 + bj * HALF;
                    f32x4 a, b; if (BF) unpack8(xh[m][bj], a, b); else { a = xa[m][bj]; b = xb[m][bj]; }
                    if (DN) { a = a * rm[m] * gi[bj][0]; b = b * rm[m] * gi[bj][1]; }
                    a = a + acc[ai][bj][m][0] * r2; b = b + acc[ai][bj][m][1] * r2; s += sumsq4(a) + sumsq4(b);
                    *(u32x4*)(XB + off) = pack8(a, b); }
                s += __shfl_xor(s, 16); s += __shfl_xor(s, 32); if (fq == 0) atomicAdd(ssq + row, s); }
            __builtin_amdgcn_sched_barrier(0);
        }
    }
};
struct EpiMlpIn {
    static constexpr bool PERM = true, AFTER_DRAIN = false;
    bf16_t* H;
    __device__ __forceinline__ void operator()(const f32x4 (&acc)[2][2][4][2], const Unit& u, int wr, int wc, int fr, int fq) const {
        const int row0 = u.pm * BM + wr * 64 + fr, c0 = u.pn * 256 + wc * 32 + 8 * fq;
        EPI_ROWS( _Pragma("unroll") for (int bj = 0; bj < 2; ++bj) { f32x4 a = acc[ai][bj][m][0], b = acc[ai][bj][m][1];
                a = __builtin_elementwise_max(a, (f32x4){0.f, 0.f, 0.f, 0.f}); b = __builtin_elementwise_max(b, (f32x4){0.f, 0.f, 0.f, 0.f});
                *(u32x4*)(H + (size_t)row * 4096 + c0 + bj * HALF) = pack8(a * a, b * b); } )
    }
};

struct EpiStore {
    static constexpr bool PERM = true, AFTER_DRAIN = false;
    bf16_t* D;
    __device__ __forceinline__ void operator()(const f32x4 (&acc)[2][2][4][2], const Unit& u, int wr, int wc, int fr, int fq) const {
        const int row0 = u.pm * BM + wr * 64 + fr, c0 = u.pn * 256 + wc * 32 + 8 * fq;
        EPI_ROWS( _Pragma("unroll") for (int bj = 0; bj < 2; ++bj) *(u32x4*)(D + (size_t)row * 1024 + c0 + bj * HALF) = pack8(acc[ai][bj][m][0], acc[ai][bj][m][1]); )
    }
};
template <class Epi, class Sched, bool ALIGN_EPI = false, bool SP2 = false>
__device__ __forceinline__ void gemm_phase(PG8_LAS unsigned char* lds, const Gemm g, const Sched& S, const Epi& E) {
    const int tid = threadIdx.x, wid = __builtin_amdgcn_readfirstlane(tid >> 6), lane = tid & 63, wr = wid >> 2, wc = wid & 3, fr = lane & 15, fq = lane >> 4;
    int K_ = g.K; asm volatile("" : "+s"(K_));
    const int K = K_, nt = K / BK;
    unsigned voffA[2], voffB[2];
#pragma unroll
    for (int i = 0; i < 2; ++i) { int R, C; stage_rc(tid * 16 + i * 8192, R, C); const int Rb = Epi::PERM ? ((R & ~31) + perm32(R & 31)) : R;
        voffA[i] = (unsigned)(R * K + C) * 2u; voffB[i] = (unsigned)(Rb * K + C) * 2u; }
    const size_t kstep = (size_t)(BK * 2);
    const size_t hstep = (size_t)HALF * K * 2;
    const size_t tstep = 2 * hstep;
    const unsigned ldsw = (unsigned)wid * 1024u;
    const int aoff = lds_byte(wr * 64 + fr, fq * 8), boff = lds_byte(wc * 32 + fr, fq * 8);
#define PG8_SA(b, h) (((b) * 2 + (h)) * HTB)
#define PG8_SB(b, h) ((4 + (b) * 2 + (h)) * HTB)
#define PG8_STAGE(bufoff, gbase, voff) do { _Pragma("unroll") for (int _i = 0; _i < 2; ++_i) \
        __builtin_amdgcn_global_load_lds((const unsigned*)((const char*)(gbase) + (voff)[_i]), (PG8_LAS unsigned*)(lds + (bufoff) + ldsw + _i * 8192), 16, 0, 0); } while (0)
#define PG8_LDA(dst, b, h) do { _Pragma("unroll") for (int m = 0; m < 4; ++m) _Pragma("unroll") for (int k = 0; k < 2; ++k) dst[m][k] = *(const PG8_LAS bf16x8*)(lds + PG8_SA(b, h) + aoff + m * 2048 + k * 1024); } while (0)
#define PG8_LDB(dst, b, h) do { _Pragma("unroll") for (int n = 0; n < 2; ++n) _Pragma("unroll") for (int k = 0; k < 2; ++k) dst[n][k] = *(const PG8_LAS bf16x8*)(lds + PG8_SB(b, h) + boff + n * 2048 + k * 1024); } while (0)
#define PG8_MMA(ai, bj, At, Bt) do { __builtin_amdgcn_s_setprio(1); _Pragma("unroll") for (int m = 0; m < 4; ++m) _Pragma("unroll") for (int n = 0; n < 2; ++n) _Pragma("unroll") for (int k = 0; k < 2; ++k) \
        acc[ai][bj][m][n] = __builtin_amdgcn_mfma_f32_16x16x32_bf16(Bt[n][k], At[m][k], acc[ai][bj][m][n], 0, 0, 0); __builtin_amdgcn_s_setprio(0); } while (0)
#define PG8_WAIT_V(n) asm volatile("s_waitcnt vmcnt(" #n ")" ::: "memory")
#define PG8_WAIT_L(n) asm volatile("s_waitcnt lgkmcnt(" #n ")" ::: "memory")
#define PG8_BAR __builtin_amdgcn_s_barrier()
#define PG8_SCHED __builtin_amdgcn_sched_barrier(0)
    Unit cur, nxt; int ui = 0;
    if (!S.next(0, cur)) return;
    f32x4 acc[2][2][4][2];
#pragma unroll
    for (int a = 0; a < 2; ++a)
#pragma unroll
        for (int b = 0; b < 2; ++b)
#pragma unroll
            for (int m = 0; m < 4; ++m)
#pragma unroll
                for (int n = 0; n < 2; ++n) acc[a][b][m][n] = (f32x4){0.f, 0.f, 0.f, 0.f};
    bf16x8 At[4][2], B0[2][2], B1[2][2];
    const char* cA = (const char*)g.A + (size_t)cur.pm * tstep; const char* cB = (const char*)g.Bt + (size_t)cur.pn * tstep;
    S.a_ready(cur);
    if constexpr (SP2) {
        PG8_STAGE(PG8_SB(0, 0), cB, voffB); PG8_STAGE(PG8_SB(0, 1), cB + hstep, voffB); PG8_STAGE(PG8_SA(0, 0), cA, voffA); PG8_STAGE(PG8_SA(0, 1), cA + hstep, voffA);
        if (wr == 1) PG8_BAR;
        PG8_WAIT_V(2); PG8_BAR;
        PG8_STAGE(PG8_SB(1, 0), cB + kstep, voffB); PG8_STAGE(PG8_SA(1, 0), cA + kstep, voffA); PG8_STAGE(PG8_SB(1, 1), cB + hstep + kstep, voffB);
        PG8_WAIT_V(6); PG8_BAR;
    } else {
        PG8_STAGE(PG8_SB(0, 0), cB, voffB); PG8_STAGE(PG8_SA(0, 0), cA, voffA); PG8_STAGE(PG8_SB(0, 1), cB + hstep, voffB); PG8_STAGE(PG8_SA(0, 1), cA + hstep, voffA);
        if (wr == 1) PG8_BAR;
        PG8_WAIT_V(4); PG8_BAR;
        PG8_STAGE(PG8_SB(1, 0), cB + kstep, voffB); PG8_STAGE(PG8_SA(1, 0), cA + kstep, voffA); PG8_STAGE(PG8_SB(1, 1), cB + hstep + kstep, voffB);
        PG8_WAIT_V(6); PG8_BAR;
    }
    for (;;) {
        const bool has_next = S.next(ui + 1, nxt);
        const char* nA = has_next ? (const char*)g.A + (size_t)nxt.pm * tstep : cA; const char* nB = has_next ? (const char*)g.Bt + (size_t)nxt.pn * tstep : cB;
        for (int t = 0; t < nt; t += 2) {
            const bool last = (t == nt - 2);
            const char* a1 = cA + (size_t)(t + 1) * kstep;
            const char* a2 = last ? nA : cA + (size_t)(t + 2) * kstep; const char* b2 = last ? nB : cB + (size_t)(t + 2) * kstep;
            const char* a3 = a2 + kstep; const char* b3 = b2 + kstep;
            if (last && has_next) S.a_ready(nxt);
            if constexpr (SP2) {
            PG8_LDB(B0, 0, 0); PG8_LDB(B1, 0, 1); PG8_SCHED; PG8_LDA(At, 0, 0); PG8_STAGE(PG8_SA(1, 1), a1 + hstep, voffA);
            PG8_WAIT_V(8); PG8_WAIT_L(0); PG8_BAR; PG8_MMA(0, 0, At, B0); PG8_MMA(0, 1, At, B1); PG8_BAR; PG8_SCHED;
            PG8_LDA(At, 0, 1); PG8_STAGE(PG8_SB(0, 0), b2, voffB); PG8_STAGE(PG8_SB(0, 1), b2 + hstep, voffB); PG8_STAGE(PG8_SA(0, 0), a2, voffA);
            PG8_WAIT_V(8); PG8_WAIT_L(0); PG8_BAR; PG8_MMA(1, 0, At, B0); PG8_MMA(1, 1, At, B1); PG8_BAR; PG8_SCHED;
            PG8_LDB(B0, 1, 0); PG8_LDB(B1, 1, 1); PG8_SCHED; PG8_LDA(At, 1, 0); PG8_STAGE(PG8_SA(0, 1), a2 + hstep, voffA);
            PG8_WAIT_V(8); PG8_WAIT_L(0); PG8_BAR; PG8_MMA(0, 0, At, B0); PG8_MMA(0, 1, At, B1); PG8_BAR; PG8_SCHED;
            PG8_LDA(At, 1, 1); PG8_STAGE(PG8_SB(1, 0), b3, voffB); PG8_STAGE(PG8_SB(1, 1), b3 + hstep, voffB); PG8_STAGE(PG8_SA(1, 0), a3, voffA);
            PG8_WAIT_V(8); PG8_WAIT_L(0); PG8_BAR; PG8_MMA(1, 0, At, B0); PG8_MMA(1, 1, At, B1); PG8_BAR; PG8_SCHED;
            } else {
            PG8_LDB(B0, 0, 0); PG8_SCHED; PG8_LDA(At, 0, 0); PG8_STAGE(PG8_SA(1, 1), a1 + hstep, voffA);
            PG8_WAIT_L(8); PG8_BAR; PG8_WAIT_L(0); PG8_MMA(0, 0, At, B0); PG8_BAR; PG8_SCHED;
            PG8_LDB(B1, 0, 1); PG8_STAGE(PG8_SB(0, 0), b2, voffB);
            PG8_BAR; PG8_WAIT_L(0); PG8_MMA(0, 1, At, B1); PG8_BAR;
            PG8_LDA(At, 0, 1); PG8_STAGE(PG8_SA(0, 0), a2, voffA);
            PG8_BAR; PG8_WAIT_L(0); PG8_MMA(1, 0, At, B0); PG8_BAR; PG8_SCHED;
            PG8_STAGE(PG8_SB(0, 1), b2 + hstep, voffB);
            PG8_WAIT_V(6); PG8_BAR; PG8_MMA(1, 1, At, B1); PG8_BAR;
            PG8_LDB(B0, 1, 0); PG8_SCHED; PG8_LDA(At, 1, 0); PG8_STAGE(PG8_SA(0, 1), a2 + hstep, voffA);
            PG8_WAIT_L(8); PG8_BAR; PG8_WAIT_L(0); PG8_MMA(0, 0, At, B0); PG8_BAR; PG8_SCHED;
            PG8_LDB(B1, 1, 1); PG8_STAGE(PG8_SB(1, 0), b3, voffB);
            PG8_BAR; PG8_WAIT_L(0); PG8_MMA(0, 1, At, B1); PG8_BAR;
            PG8_LDA(At, 1, 1); PG8_STAGE(PG8_SA(1, 0), a3, voffA);
            PG8_BAR; PG8_WAIT_L(0); PG8_MMA(1, 0, At, B0); PG8_BAR; PG8_SCHED;
            PG8_STAGE(PG8_SB(1, 1), b3 + hstep, voffB);
            PG8_WAIT_V(6); PG8_BAR; PG8_MMA(1, 1, At, B1); PG8_BAR;
            }
        }
        if constexpr (ALIGN_EPI) { if (wr == 0) PG8_BAR; }
        if constexpr (!Epi::AFTER_DRAIN) { E(acc, cur, wr, wc, fr, fq); S.done(cur); }
        if (!has_next) break;
#pragma unroll
        for (int a = 0; a < 2; ++a)
#pragma unroll
            for (int b = 0; b < 2; ++b)
#pragma unroll
                for (int m = 0; m < 4; ++m)
#pragma unroll
                    for (int n = 0; n < 2; ++n) acc[a][b][m][n] = (f32x4){0.f, 0.f, 0.f, 0.f};
        cur = nxt; cA = nA; cB = nB; ++ui;
        if constexpr (ALIGN_EPI) { if (wr == 1) PG8_BAR; }
    }
    PG8_WAIT_V(0);
    if constexpr (!ALIGN_EPI) { if (wr == 0) PG8_BAR; }
    PG8_BAR;
    if constexpr (Epi::AFTER_DRAIN) { E.fused(acc, cur, wr, wc, fr, fq, lds, wid, lane); S.done(cur); }
#undef PG8_SA
#undef PG8_SB
#undef PG8_STAGE
#undef PG8_LDA
#undef PG8_LDB
#undef PG8_MMA
#undef PG8_WAIT_V
#undef PG8_WAIT_L
#undef PG8_BAR
#undef PG8_SCHED
}
}
namespace att {
constexpr int SEQ = 4096, NH = 8, QP = 1536, KNP = 128, KRP = 64, VP = 128, OP = 1024;
constexpr float SCALE = 0.07216878364870322f;
constexpr float THR = 8.f;
constexpr int NW = 8, QBLK = 32, KVBLK = 64, QB = NW * QBLK;
constexpr int KROW = 512;
constexpr int SHM_V = KVBLK * 128 * 2, SHM_K = KVBLK * KROW;
constexpr int LDS_BYTES = 3 * SHM_V + 2 * SHM_K + NW * 64 * 4;
constexpr int WIN = 1 << 30;
typedef short bf16x8 __attribute__((ext_vector_type(8)));
typedef short s16x4 __attribute__((ext_vector_type(4)));
typedef float f32x16 __attribute__((ext_vector_type(16)));
typedef float f32x4 __attribute__((ext_vector_type(4)));
typedef unsigned u32x4 __attribute__((ext_vector_type(4)));
typedef unsigned short bf16;
#define KSWZ(row, colB) ((row) * KROW + ((colB) ^ (((row) & 15) << 4)))
#define SBAR() __builtin_amdgcn_sched_barrier(0)
__device__ __forceinline__ int v_st(int k, int c) { const int kk = (k & ~0xC) | ((k & 4) << 1) | ((k & 8) >> 1); return ((kk >> 3) * 4 + (c >> 5)) * 512 + ((kk & 7) * 32 + (c & 31)) * 2; }
__device__ __forceinline__ int v_rd_base(int lane) { return ((lane & 3) << 3) | (((lane >> 2) & 3) << 6) | (((lane >> 4) & 1) << 5) | (((lane >> 5) & 1) << 8); }
constexpr int v_rd_off(int d0, int ks, int half) { return d0 * 512 + ks * 4096 + half * 2048; }
__device__ __forceinline__ int crow(int r, int hi) { return (r & 3) + 8 * (r >> 2) + 4 * hi; }
typedef float f32x2_cv __attribute__((ext_vector_type(2))); typedef __bf16 bf16x2_cv __attribute__((ext_vector_type(2)));
__device__ __forceinline__ unsigned cvtpk(float lo, float hi) { f32x2_cv v = {lo, hi}; bf16x2_cv b = __builtin_convertvector(v, bf16x2_cv); return __builtin_bit_cast(unsigned, b); }
__device__ __forceinline__ bf16x8 load8(const bf16* p) { return *reinterpret_cast<const bf16x8*>(p); }
__device__ __forceinline__ void mask_tile(f32x16& p0, f32x16& p1, int dq, unsigned W) {
    const float NEG = -__builtin_inff();
#pragma unroll
    for (int r = 0; r < 16; ++r) {
        const int c = (r & 3) + 8 * (r >> 2);
        if ((unsigned)(dq - c) >= W) p0[r] = NEG;
        if ((unsigned)(dq - c - 32) >= W) p1[r] = NEG;
    }
}
__device__ __forceinline__ void partialSM(f32x16& p0, f32x16& p1, float& m_reg, float& mn, float& alpha) {
    float pmax = p0[0]; for (int r = 1; r < 16; ++r) pmax = fmaxf(pmax, p0[r]); for (int r = 0; r < 16; ++r) pmax = fmaxf(pmax, p1[r]);
    { auto rr = __builtin_amdgcn_permlane32_swap(__float_as_uint(pmax), __float_as_uint(pmax), false, false);
      pmax = fmaxf(__uint_as_float(rr[0]), __uint_as_float(rr[1])); }
    constexpr float C2 = 1.4426950408889634f * SCALE;
    if (__builtin_expect(__all((pmax - m_reg) * SCALE <= THR), 1)) { mn = m_reg; alpha = 1.f; }
    else { mn = fmaxf(m_reg, pmax); alpha = __builtin_amdgcn_exp2f((m_reg - mn) * C2); m_reg = mn; }
    const float mnL = -mn * C2;
    for (int r = 0; r < 16; ++r) p0[r] = fmaf(p0[r], C2, mnL); for (int r = 0; r < 16; ++r) p1[r] = fmaf(p1[r], C2, mnL);
    for (int r = 0; r < 16; ++r) p0[r] = __builtin_amdgcn_exp2f(p0[r]);
}
__device__ __forceinline__ void finishSM(f32x16& p0, f32x16& p1, float alpha, float& l_reg, bf16x8& pa0, bf16x8& pa1, bf16x8& pa2, bf16x8& pa3) {
    for (int r = 0; r < 16; ++r) p1[r] = __builtin_amdgcn_exp2f(p1[r]);
    float ps = 0; for (int r = 0; r < 16; ++r) ps += p0[r]; for (int r = 0; r < 16; ++r) ps += p1[r];
    { auto rr = __builtin_amdgcn_permlane32_swap(__float_as_uint(ps), __float_as_uint(ps), false, false);
      ps = __uint_as_float(rr[0]) + __uint_as_float(rr[1]); }
    l_reg = l_reg * alpha + ps;
#define PK4(P, B_, OUT) do { unsigned a0 = cvtpk(P[B_+0], P[B_+1]), a1 = cvtpk(P[B_+2], P[B_+3]);                          \
        unsigned b0 = cvtpk(P[B_+4], P[B_+5]), b1 = cvtpk(P[B_+6], P[B_+7]);                                             \
        auto r0 = __builtin_amdgcn_permlane32_swap(a0, b0, false, false); auto r1 = __builtin_amdgcn_permlane32_swap(a1, b1, false, false); \
        u32x4 w = {r0[0], r1[0], r0[1], r1[1]}; OUT = *reinterpret_cast<bf16x8*>(&w); } while (0)
    PK4(p0, 0, pa0); PK4(p0, 8, pa1); PK4(p1, 0, pa2); PK4(p1, 8, pa3);
#undef PK4
}
template <int KB>
__device__ __forceinline__ void qkt(f32x16& p0, f32x16& p1, const char* K_lds, int r32, int hi, const bf16x8* qr) {
    p0 = f32x16{}; p1 = f32x16{};
    int kb[8];
#pragma unroll
    for (int dd = 0; dd < 8; ++dd) kb[dd] = (int)(uintptr_t)K_lds + KSWZ(r32, (dd * 16 + hi * 8) * 2);
    bf16x8 f0[4], f1[4];
#define KRD(d) do { asm volatile("ds_read_b128 %0, %1 offset:%2" : "=&v"(f0[(d) & 3]) : "v"(kb[(d) & 7]), "i"(KB * SHM_K + ((d) >> 3) * 256) : "memory");              \
                    asm volatile("ds_read_b128 %0, %1 offset:%2" : "=&v"(f1[(d) & 3]) : "v"(kb[(d) & 7]), "i"(KB * SHM_K + ((d) >> 3) * 256 + 32 * KROW) : "memory"); } while (0)
#define KMM(d, n) do { asm volatile("s_waitcnt lgkmcnt(" #n ")" ::: "memory"); SBAR();                                                                                 \
                       p0 = __builtin_amdgcn_mfma_f32_32x32x16_bf16(f0[(d) & 3], qr[d], p0, 0, 0, 0); p1 = __builtin_amdgcn_mfma_f32_32x32x16_bf16(f1[(d) & 3], qr[d], p1, 0, 0, 0); SBAR(); } while (0)
    KRD(0); KRD(1); KRD(2);
    __builtin_amdgcn_s_setprio(1);
    KRD(3); KMM(0, 6); KRD(4); KMM(1, 6); KRD(5); KMM(2, 6); KRD(6); KMM(3, 6); KRD(7); KMM(4, 6); KRD(8); KMM(5, 6);
    KRD(9); KMM(6, 6); KRD(10); KMM(7, 6); KRD(11); KMM(8, 6); KMM(9, 4); KMM(10, 2); KMM(11, 0);
    __builtin_amdgcn_s_setprio(0);
#undef KRD
#undef KMM
}
template <int VB>
__device__ __forceinline__ void pv_tile(f32x16* o, int vb0, bf16x8 pa0, bf16x8 pa1, bf16x8 pa2, bf16x8 pa3) {
#define TRRD(dst, off) asm volatile("ds_read_b64_tr_b16 %0, %1 offset:%2" : "=&v"(dst) : "v"(vb0), "i"(off) : "memory")
#define PV_RD(S_, d0) do { constexpr int b_ = VB * SHM_V + v_rd_off(d0, 0, 0); \
        TRRD(S_##l0, b_); TRRD(S_##h0, b_ + 2048); TRRD(S_##l1, b_ + 4096); TRRD(S_##h1, b_ + 6144); TRRD(S_##l2, b_ + 8192); TRRD(S_##h2, b_ + 10240); TRRD(S_##l3, b_ + 12288); TRRD(S_##h3, b_ + 14336); } while (0)
#define PV_MM(S_, d0) do { \
        o[d0] = __builtin_amdgcn_mfma_f32_32x32x16_bf16(pa0, (bf16x8){S_##l0[0], S_##l0[1], S_##l0[2], S_##l0[3], S_##h0[0], S_##h0[1], S_##h0[2], S_##h0[3]}, o[d0], 0, 0, 0);   \
        o[d0] = __builtin_amdgcn_mfma_f32_32x32x16_bf16(pa1, (bf16x8){S_##l1[0], S_##l1[1], S_##l1[2], S_##l1[3], S_##h1[0], S_##h1[1], S_##h1[2], S_##h1[3]}, o[d0], 0, 0, 0);   \
        o[d0] = __builtin_amdgcn_mfma_f32_32x32x16_bf16(pa2, (bf16x8){S_##l2[0], S_##l2[1], S_##l2[2], S_##l2[3], S_##h2[0], S_##h2[1], S_##h2[2], S_##h2[3]}, o[d0], 0, 0, 0);   \
        o[d0] = __builtin_amdgcn_mfma_f32_32x32x16_bf16(pa3, (bf16x8){S_##l3[0], S_##l3[1], S_##l3[2], S_##l3[3], S_##h3[0], S_##h3[1], S_##h3[2], S_##h3[3]}, o[d0], 0, 0, 0); } while (0)
#define LW(n) asm volatile("s_waitcnt lgkmcnt(" #n ")" ::: "memory")
    s16x4 Al0, Al1, Al2, Al3, Ah0, Ah1, Ah2, Ah3, Bl0, Bl1, Bl2, Bl3, Bh0, Bh1, Bh2, Bh3;
    PV_RD(A, 0); PV_RD(B, 1); LW(8); SBAR(); __builtin_amdgcn_s_setprio(1);
    PV_MM(A, 0); SBAR(); PV_RD(A, 2); LW(8); SBAR();
    PV_MM(B, 1); SBAR(); PV_RD(B, 3); LW(8); SBAR();
    PV_MM(A, 2); SBAR(); LW(0); SBAR();
    PV_MM(B, 3); __builtin_amdgcn_s_setprio(0);
#undef LW
#undef PV_MM
#undef PV_RD
#undef TRRD
}
struct BlockRef { const bf16* Q; const bf16* KN; const bf16* KR; const bf16* V; bf16* O; int P0; };
struct Seam { bf16x8 qr[12]; bf16x8 st_k0, st_k1, st_k2; };
#define VMW() asm volatile("s_waitcnt vmcnt(0)" ::: "memory")
#define VMWN(n) asm volatile("s_waitcnt vmcnt(%0)" :: "i"(n) : "memory")
#define SLOAD_H(R, k0) do { S.st_k0 = load8((R).KN + (size_t)((k0) + sr) * KNP + sc); S.st_k1 = load8((R).KN + (size_t)((k0) + 32 + sr) * KNP + sc);     \
                            S.st_k2 = load8((R).KR + (size_t)((k0) + kr) * KRP + rc); } while (0)
#define SWRITE_HK(bf) do { *(bf16x8*)(K_lds + (bf) * SHM_K + kws) = S.st_k0; *(bf16x8*)(K_lds + (bf) * SHM_K + kws + 32 * KROW) = S.st_k1; *(bf16x8*)(K_lds + (bf) * SHM_K + kws2) = S.st_k2; } while (0)
#define SWRITE_HV(bf) do { *(bf16x8*)(V_lds + (bf) * SHM_V + vst0) = S.st_k0; *(bf16x8*)(V_lds + (bf) * SHM_V + vst1) = S.st_k1; } while (0)
#define SWRITE_H(bf) do { SWRITE_HV(bf); SWRITE_HK(bf); } while (0)
__device__ __forceinline__ BlockRef make_ref(int L, int pass, const bf16* Q, const bf16* KN, const bf16* KR, const bf16* V, bf16* O) {
    const int bh = L >> 3, x = L & 7, qb = pass ? 15 - x : x, b = bh / NH, h = bh % NH;
    const size_t r0 = (size_t)b * SEQ;
    BlockRef r; r.Q = Q + (r0 + (size_t)qb * QB) * QP + h * 192; r.O = O + (r0 + (size_t)qb * QB) * OP + h * 128;
    r.KN = KN + r0 * KNP; r.KR = KR + r0 * KRP; r.V = V + r0 * VP; r.P0 = qb * QB;
    return r;
}
__device__ __forceinline__ void attn_phase(char* lds, const bf16* Q, const bf16* KN, const bf16* KR, const bf16* V, bf16* O, int first, int stride, int total) {
    if (first >= total) return;
    const int tid = threadIdx.x, wid = __builtin_amdgcn_readfirstlane(tid >> 6), lane = tid & 63, r32 = lane & 31, hi = lane >> 5; const bool grpB = wid >= 4;
    char* V_lds = lds; char* K_lds = lds + 3 * SHM_V;
    float* ws = (float*)(lds + 3 * SHM_V + 2 * SHM_K) + wid * 64; float* li_l = ws, * al_l = ws + 32;
    const int sr = tid >> 4, sc = (tid & 15) * 8, vst0 = v_st(sr, sc), vst1 = v_st(32 + sr, sc), kws = KSWZ(sr, sc * 2), kr = tid >> 3, rc = (tid & 7) * 8, kws2 = KSWZ(kr, (128 + rc) * 2);
    const int vb0 = (int)(uintptr_t)V_lds + v_rd_base(lane);
    Seam S;
    int cL = first, cpass = 0;
    BlockRef cur = make_ref(cL, 0, Q, KN, KR, V, O), nxt = cur; bool has_nxt;
#define ADVANCE() do { if (cpass == 0) { cpass = 1; has_nxt = true; } else if (cL + stride < total) { cL += stride; cpass = 0; has_nxt = true; } else has_nxt = false; \
                       if (has_nxt) nxt = make_ref(cL, cpass, Q, KN, KR, V, O); } while (0)
    ADVANCE();
    float m_reg = -1e30f, l_reg = 0; f32x16 o[4] = {};
    f32x16 p0, p1; float mn, al; bf16x8 pa0, pa1, pa2, pa3;
    int vs = 0; bool sv = false, qpend = false, more = true;
#pragma unroll
    for (int d0 = 0; d0 < 12; ++d0) S.qr[d0] = load8(cur.Q + (size_t)(wid * QBLK + r32) * QP + d0 * 16 + hi * 8);
    SLOAD_H(cur, 0); VMW(); SWRITE_HV(0); SWRITE_HK(0);
    __syncthreads();
    SLOAD_H(cur, KVBLK); sv = true;
#define RESC(a) do { if (__any((a) < 1.f)) { if (hi == 0) al_l[r32] = (a); asm volatile("s_waitcnt lgkmcnt(0)" ::: "memory");              \
                     for (int d_ = 0; d_ < 4; ++d_) for (int r = 0; r < 16; ++r) o[d_][r] *= al_l[crow(r, hi)]; } } while (0)
#define MASKT(P0_, P1_, t) do { const int kb_ = (t) * KVBLK; if (kb_ + KVBLK - 1 > qlo) mask_tile(P0_, P1_, qm - kb_, (unsigned)WIN); } while (0)
#define EPILOGUE(Optr) do { if (hi == 0) li_l[r32] = l_reg; asm volatile("s_waitcnt lgkmcnt(0)" ::: "memory");                              \
        { float rli[16]; _Pragma("unroll") for (int r = 0; r < 16; ++r) rli[r] = __builtin_amdgcn_rcpf(li_l[crow(r, hi)]);                   \
          bf16* Ow = (Optr) + (size_t)(wid * QBLK) * OP;                                                                                     \
          _Pragma("unroll") for (int r = 0; r < 16; ++r) { const int orow = crow(r, hi);                                                     \
            _Pragma("unroll") for (int d0 = 0; d0 < 4; ++d0) { const float v = o[d0][r] * rli[r]; const float vn = __shfl_xor(v, 1);         \
                if ((r32 & 1) == 0) *(unsigned*)(Ow + (size_t)orow * OP + d0 * 32 + r32) = cvtpk(v, vn); } } }                               \
        m_reg = -1e30f; l_reg = 0; o[0] = f32x16{}; o[1] = f32x16{}; o[2] = f32x16{}; o[3] = f32x16{}; } while (0)
#define END_STEP(t, KB) do { const int vsn_ = (vs == 2) ? 0 : vs + 1;                                                                   \
        if (sv) { if (qpend) { VMWN(12); } else { VMW(); } SWRITE_HV(vsn_); SWRITE_HK((KB) ^ 1); sv = false; } qpend = false;             \
        __syncthreads();                                                                                                                 \
        if ((t) + 2 < NT) { SLOAD_H(cur, ((t) + 2) * KVBLK); sv = true; } else if (has_nxt) { SLOAD_H(nxt, ((t) + 2 - NT) * KVBLK); sv = true; } SBAR(); } while (0)
#define TILE(t, KB, LASTQ) do {                                                                                                         \
        qkt<KB>(p0, p1, K_lds, r32, hi, S.qr); SBAR();                                                                                   \
        if (LASTQ) { if ((t) + 1 >= NT && has_nxt) { _Pragma("unroll") for (int d0 = 0; d0 < 12; ++d0) S.qr[d0] = load8(nxt.Q + (size_t)(wid * QBLK + r32) * QP + d0 * 16 + hi * 8); qpend = true; } SBAR(); } \
        MASKT(p0, p1, (t)); partialSM(p0, p1, m_reg, mn, al); finishSM(p0, p1, al, l_reg, pa0, pa1, pa2, pa3); RESC(al); SBAR();         \
        if (grpB) END_STEP(t, KB);                                                                                                       \
        pv_tile<0>(o, vb0 + vs * SHM_V, pa0, pa1, pa2, pa3); SBAR();                                                                     \
        if (!grpB) END_STEP(t, KB);                                                                                                      \
        vs = (vs == 2) ? 0 : vs + 1; } while (0)
    while (more) {
        const int NT = (cur.P0 + QB - 1) / KVBLK + 1, qlo = cur.P0 + wid * QBLK, qm = qlo + r32 - 4 * hi;
        for (int t = 0; t < NT; t += 2) { TILE(t, 0, false); TILE(t + 1, 1, true); }
        EPILOGUE(cur.O);
        more = has_nxt; if (more) { cur = nxt; ADVANCE(); }
    }
    __syncthreads();
#undef END_STEP
#undef TILE
#undef ADVANCE
#undef RESC
#undef MASKT
#undef EPILOGUE
}
#undef VMW
#undef VMWN
#undef SLOAD_H
#undef SWRITE_HK
#undef SWRITE_HV
#undef SWRITE_H
#undef KSWZ
#undef SBAR
}
#ifndef MK_LAUNCHES
#define MK_LAUNCHES 1
#endif
constexpr int NWAVES = 8;
constexpr int BATCH = 16, SEQ = 4096, DM = 1024, M = BATCH * SEQ, FF = 4096, NZ = 3072, IN_COLS = 3008;
constexpr float EPS = 1e-6f;
constexpr size_t MiB = 1u << 20;
constexpr size_t WS_SSQ = 1 * MiB;
constexpr size_t WS_WIN = 2 * MiB, WS_WUQ = 8 * MiB, WS_WUKV = 9 * MiB, WS_WCOMB = 10 * MiB, WS_WATT = 11 * MiB, WS_WOUT = 13 * MiB, WS_W1 = 15 * MiB, WS_W2 = 23 * MiB;
constexpr size_t WS_XN = 32 * MiB;
constexpr size_t WS_U = 160 * MiB, WS_CQ = 224 * MiB, WS_CKV = 256 * MiB;
constexpr size_t WS_O = 160 * MiB;
constexpr size_t WS_GA = 288 * MiB, WS_GB = 416 * MiB, WS_POOLED = 544 * MiB, WS_Q = 608 * MiB, WS_KN = 800 * MiB;
constexpr size_t WS_KR = 928 * MiB, WS_COS = 936 * MiB, WS_SIN = 944 * MiB, WS_END = 952 * MiB;
constexpr size_t WS_H = 416 * MiB;
constexpr int RING_BYTES = 131072, LDS_BYTES = 147456;

#define GAS __attribute__((address_space(1)))
#define LAS __attribute__((address_space(3)))
typedef unsigned short bf16;
typedef unsigned v4u __attribute__((ext_vector_type(4)));
typedef float f32x4 __attribute__((ext_vector_type(4)));
#define LDS_WAIT() asm volatile("s_waitcnt lgkmcnt(0)" ::: "memory")
__device__ __forceinline__ unsigned f2bf(float f) { unsigned u = __builtin_bit_cast(unsigned, f); return (u + 0x7fffu + ((u >> 16) & 1u)) >> 16; }
__device__ __forceinline__ unsigned pk2(float lo, float hi) { return f2bf(lo) | (f2bf(hi) << 16); }
__device__ __forceinline__ float bflo(unsigned w) { return __uint_as_float(w << 16); }
__device__ __forceinline__ float bfhi(unsigned w) { return __uint_as_float(w & 0xffff0000u); }
__device__ __forceinline__ float wave_sum(float v) {
#pragma unroll
    for (int o = 1; o < 64; o <<= 1) v += __shfl_xor(v, o);
    return v;
}
struct Args {
    const float* x; const int* pos; const float *g_mix, *w_in, *b_gate, *pool_w, *pool_scale, *w_pool_proj, *g_q, *w_uq, *g_kv, *w_ukv, *w_attn, *w_out, *g_mlp, *w1, *w2, *g_final;
    float* out; unsigned char* ws; int ph_lo, ph_hi;
};
struct MapId { static __device__ __forceinline__ int src(int j) { return j; } };
struct MapWin { static __device__ __forceinline__ int src(int j) { if (j < 896) return j; if (j < 960) { const int jj = j - 896; return 896 + (jj & 1) * 32 + (jj >> 1); } if (j < 1024) return -1; return j - 64; } };
struct MapWuq { static __device__ __forceinline__ int src(int j) { if (j < 1024) return (j >> 7) * 192 + (j & 127); const int jj = j - 1024, h = jj >> 6, r = jj & 63; return h * 192 + 128 + (r & 1) * 32 + (r >> 1); } };
template <class MAP> __device__ __forceinline__ void transpose_item(const float* W, int K, int Nsrc, int nblk, bf16* WT, const float* rs, LAS float* scr, int item, int lane, int nb0 = 0) {
    const int kb = item / nblk, nb = nb0 + item % nblk, k0 = 64 * kb, n0 = 32 * nb;
    const int s = MAP::src(n0 + (lane & 31));
#pragma unroll 8
    for (int i = 0; i < 32; ++i) { const int kk = 2 * i + (lane >> 5); float v = 0.f; if (s >= 0) { v = W[(size_t)(k0 + kk) * Nsrc + s]; if (rs) v *= rs[k0 + kk]; } scr[kk * 33 + (lane & 31)] = v; }
    LDS_WAIT(); asm volatile("" ::: "memory");
    const int c = lane & 7;
#pragma unroll
    for (int j = 0; j < 4; ++j) { const int n = (lane >> 3) + 8 * j; const LAS float* sp = scr + (8 * c) * 33 + n;
        v4u o; o.x = pk2(sp[0 * 33], sp[1 * 33]); o.y = pk2(sp[2 * 33], sp[3 * 33]); o.z = pk2(sp[4 * 33], sp[5 * 33]); o.w = pk2(sp[6 * 33], sp[7 * 33]);
        *(GAS v4u*)(WT + (size_t)(n0 + n) * K + k0 + 8 * c) = o; }
    LDS_WAIT(); asm volatile("" ::: "memory");
}

#define XB_TMO      128
#define XB_XCNT(j)  (256  + 64 * (j))
#define XB_XSUB(j)  (1280 + 64 * (j))
#define XB_XGEN(j)  (2304 + 64 * (j))
#define XB_TOP      3328
#define XB_TOPGEN   3392
#define XCD_BAR_WORDS 3456
#define XB_SPIN_CAP (1u << 18)

__device__ __forceinline__ unsigned xb_ld(unsigned* p)              { return __hip_atomic_load(p, __ATOMIC_RELAXED, __HIP_MEMORY_SCOPE_AGENT); }
__device__ __forceinline__ unsigned xb_add(unsigned* p, unsigned v) { return __hip_atomic_fetch_add(p, v, __ATOMIC_RELAXED, __HIP_MEMORY_SCOPE_AGENT); }
__device__ __forceinline__ unsigned xb_xcc_id() { return (unsigned)__builtin_amdgcn_s_getreg((3 << 11) | 20) & 0xFu; }
#define XB_SPIN(cond, bar) do { unsigned _sp = 0; while (cond) { __builtin_amdgcn_s_sleep(1); \
    if ((++_sp & 255u) == 0u) { if (xb_ld(&(bar)[XB_TMO])) break; if (_sp > XB_SPIN_CAP) { atomicAdd(&(bar)[XB_TMO], 1u); break; } } } } while (0)

struct XcdBarrier {
    unsigned* bar; unsigned x;
    volatile LAS unsigned* st;
};

__device__ __forceinline__ XcdBarrier xcd_barrier_post(unsigned* bar, volatile LAS unsigned* st) {
    XcdBarrier b; b.bar = bar; b.x = xb_xcc_id(); b.st = st;
    if (threadIdx.x == 0) (void)xb_add(&bar[XB_XCNT(b.x)], 1u);
    return b;
}
__device__ __forceinline__ void xcd_barrier_complete(unsigned* bar, unsigned x, unsigned& nloc, unsigned& nx) {
    const unsigned G = gridDim.x * gridDim.y * gridDim.z;
    unsigned sum, cnt, mine, sp = 0u;
    for (;;) {
        sum = 0u; cnt = 0u; mine = 0u;
#pragma unroll
        for (unsigned j = 0; j < 16; ++j) { const unsigned c = xb_ld(&bar[XB_XCNT(j)]); sum += c; cnt += (c > 0u) ? 1u : 0u; mine = (j == x) ? c : mine; }
        if (sum == G) break;
        __builtin_amdgcn_s_sleep(1);
        if ((++sp & 255u) == 0u) { if (xb_ld(&bar[XB_TMO])) break; if (sp > XB_SPIN_CAP) { atomicAdd(&bar[XB_TMO], 1u); break; } }
    }
    nloc = mine > 0u ? mine : 1u; nx = cnt > 0u ? cnt : 1u;
}

__device__ __forceinline__ void xcd_barrier(const XcdBarrier& b) {
    asm volatile("s_waitcnt vmcnt(0)" ::: "memory");
    __syncthreads();
    if (threadIdx.x == 0) {
        unsigned* bar = b.bar;
        __builtin_amdgcn_s_waitcnt(0);
        unsigned nloc = b.st[0], nx = b.st[1];
        if (nloc == 0u) { xcd_barrier_complete(bar, b.x, nloc, nx); b.st[0] = nloc; b.st[1] = nx; }
        const unsigned old = xb_add(&bar[XB_XSUB(b.x)], 1u);
        const unsigned gen = old / nloc;
        if (old + 1u == (gen + 1u) * nloc) {
            __builtin_amdgcn_fence(__ATOMIC_RELEASE, "agent");
            asm volatile("s_waitcnt vmcnt(0)" ::: "memory");
            const unsigned og = xb_add(&bar[XB_TOP], 1u);
            const unsigned tg = og / nx;
            if (og + 1u == (tg + 1u) * nx) xb_add(&bar[XB_TOPGEN], 1u);
            else XB_SPIN(xb_ld(&bar[XB_TOPGEN]) == tg, bar);
            __builtin_amdgcn_fence(__ATOMIC_ACQUIRE, "agent");
            xb_add(&bar[XB_XGEN(b.x)], 1u);
            asm volatile("s_waitcnt vmcnt(0)" ::: "memory");
        } else {
            XB_SPIN(xb_ld(&bar[XB_XGEN(b.x)]) == gen, bar);
            __builtin_amdgcn_fence(__ATOMIC_ACQUIRE, "agent");
            asm volatile("s_waitcnt vmcnt(0)" ::: "memory");
        }
    }
    __syncthreads();
}

__global__ void __launch_bounds__(NWAVES * 64, 2) mk_fwd(Args a) {
    extern __shared__ __attribute__((aligned(16))) unsigned char lds[];
    cg::grid_group grid = cg::this_grid();
    const int tid = threadIdx.x, lane = tid & 63, wave = __builtin_amdgcn_readfirstlane(tid >> 6);
    const int G = gridDim.x, bx = blockIdx.x, vcu = (G % 8 == 0) ? (bx % 8) * (G / 8) + bx / 8 : bx;
    const int gw = vcu * NWAVES + wave, NGW = G * NWAVES;
    unsigned char* ws = a.ws;
    float* ssq_q = (float*)(ws + WS_SSQ); float* ssq_kv = ssq_q + M; float* ssq1 = ssq_kv + M; float* ssq2 = ssq1 + M;
    bf16 *Win_t = (bf16*)(ws + WS_WIN), *Wuq_t = (bf16*)(ws + WS_WUQ), *Wcomb_t = (bf16*)(ws + WS_WCOMB), *Watt_t = (bf16*)(ws + WS_WATT), *Wout_t = (bf16*)(ws + WS_WOUT), *W1_t = (bf16*)(ws + WS_W1), *W2_t = (bf16*)(ws + WS_W2);
    bf16 *XN = (bf16*)(ws + WS_XN), *X1B = (bf16*)(ws + WS_XN), *X2B = (bf16*)(ws + WS_O);
    bf16 *U = (bf16*)(ws + WS_U), *CQ = (bf16*)(ws + WS_CQ), *CKV = (bf16*)(ws + WS_CKV), *Ob = (bf16*)(ws + WS_O);
    bf16 *GA = (bf16*)(ws + WS_GA), *GB = (bf16*)(ws + WS_GB), *POOLED = (bf16*)(ws + WS_POOLED), *Qb = (bf16*)(ws + WS_Q), *LAT = (bf16*)(ws + WS_KN), *KR = (bf16*)(ws + WS_KR), *Hb = (bf16*)(ws + WS_H);
    float *cosT = (float*)(ws + WS_COS), *sinT = (float*)(ws + WS_SIN), *rms0 = (float*)(ws + 31 * MiB);
    PG8_LAS unsigned char* ring = (PG8_LAS unsigned char*)lds;
    const int lo = a.ph_lo, hi = a.ph_hi;
    volatile LAS unsigned* xst = (volatile LAS unsigned*)((LAS unsigned char*)lds + RING_BYTES);
    if (tid < 2) xst[tid] = 0u;
    __syncthreads();
    XcdBarrier bar; bar.bar = (unsigned*)ws; bar.x = 0; bar.st = xst;
    if (hi - lo > 1) bar = xcd_barrier_post((unsigned*)ws, xst);
    if (lo > 1000) grid.sync();
#ifdef ONLYP
#define IN(k) ((k) == ONLYP && lo <= (k) && (k) < hi)
#else
#define IN(k) (lo <= (k) && (k) < hi)
#endif
#define SEAM(k) do { if (IN(k) && IN((k) + 1)) xcd_barrier(bar); } while (0)

    if (IN(0)) {
        LAS float* scr = (LAS float*)((LAS unsigned char*)lds + wave * 16384);
        constexpr int I_IN = 16 * 96, I_UQ = 4 * 16, I_QABS = 512, I_ATT = 2048, I_OUT = 16 * 32, I_1 = 16 * 128, I_2 = 64 * 32, I_COMB = 1024;
        constexpr int NITEMS = I_IN + I_UQ + I_QABS + I_ATT + I_OUT + I_1 + I_2 + I_COMB;
        const int hw = gw >> 1, NHW = NGW >> 1;
        if (wave & 1) {
        for (int it = hw; it < NITEMS; it += NHW) {
            int r = it;
            if (r < I_IN) { transpose_item<MapWin>(a.w_in, 1024, IN_COLS, 96, Win_t, nullptr, scr, r, lane); continue; } r -= I_IN;
            if (r < I_UQ) { transpose_item<MapWuq>(a.w_uq, 256, 1536, 16, Wuq_t, a.g_q, scr, r, lane, 32); continue; } r -= I_UQ;
            if (r < I_QABS) {
                for (int e = r * 64 + lane; e < 1024 * 32; e += I_QABS * 64) { const int row = e >> 5, k8 = e & 31, h = row >> 7, j = row & 127;
                    float acc8[8] = {0.f, 0.f, 0.f, 0.f, 0.f, 0.f, 0.f, 0.f};
                    const float* kvp = a.w_ukv + (size_t)j * 2048 + h * 256; const float* uqp = a.w_uq + (size_t)(k8 * 8) * 1536 + h * 192;
                    for (int d4 = 0; d4 < 32; ++d4) { const f32x4 kv = *(const f32x4*)(kvp + 4 * d4);
#pragma unroll
                        for (int i = 0; i < 8; ++i) { const f32x4 uq = *(const f32x4*)(uqp + (size_t)i * 1536 + 4 * d4); acc8[i] += (kv.x * uq.x + kv.y * uq.y) + (kv.z * uq.z + kv.w * uq.w); } }
                    const float gj = a.g_kv[j]; const float* gq = a.g_q + k8 * 8;
                    v4u o; o.x = pk2(acc8[0] * gj * gq[0], acc8[1] * gj * gq[1]); o.y = pk2(acc8[2] * gj * gq[2], acc8[3] * gj * gq[3]); o.z = pk2(acc8[4] * gj * gq[4], acc8[5] * gj * gq[5]); o.w = pk2(acc8[6] * gj * gq[6], acc8[7] * gj * gq[7]);
                    *(GAS v4u*)(Wuq_t + (size_t)row * 256 + k8 * 8) = o; }
                continue; } r -= I_QABS;
            if (r < I_ATT) {
                const int nblk = r & 15, kk8 = r >> 4, h = kk8 >> 4, j0 = (kk8 & 15) * 8, n = nblk * 64 + lane;
                float acc8[8] = {0.f, 0.f, 0.f, 0.f, 0.f, 0.f, 0.f, 0.f};
                const float* kvp = a.w_ukv + (size_t)j0 * 2048 + h * 256 + 128;
                for (int d = 0; d < 128; ++d) { const float w = a.w_attn[(size_t)(h * 128 + d) * 1024 + n];
#pragma unroll
                    for (int i = 0; i < 8; ++i) acc8[i] += kvp[(size_t)i * 2048 + d] * w; }
                const float* gk = a.g_kv + j0;
                v4u o; o.x = pk2(acc8[0] * gk[0], acc8[1] * gk[1]); o.y = pk2(acc8[2] * gk[2], acc8[3] * gk[3]); o.z = pk2(acc8[4] * gk[4], acc8[5] * gk[5]); o.w = pk2(acc8[6] * gk[6], acc8[7] * gk[7]);
                *(GAS v4u*)(Watt_t + (size_t)n * 1024 + h * 128 + j0) = o;
                continue; } r -= I_ATT;
            if (r < I_OUT) { transpose_item<MapId>(a.w_out, 1024, 1024, 32, Wout_t, nullptr, scr, r, lane); continue; } r -= I_OUT;
            if (r < I_1) { transpose_item<MapId>(a.w1, 1024, 4096, 128, W1_t, a.g_mlp, scr, r, lane); continue; } r -= I_1;
            if (r < I_2) { transpose_item<MapId>(a.w2, 4096, 1024, 32, W2_t, nullptr, scr, r, lane); continue; } r -= I_2;
            {
                const int g = r >> 8, c8 = (r >> 4) & 15, d = (r & 15) * 64 + lane;
                float acc8[8] = {0.f, 0.f, 0.f, 0.f, 0.f, 0.f, 0.f, 0.f};
                const float* pw = a.pool_w + (size_t)(g * 128 + c8 * 8) * 128;
                for (int e = 0; e < 128; ++e) { const float w = a.w_pool_proj[(size_t)(g * 128 + e) * 1024 + d] * a.pool_scale[g * 128 + e];
#pragma unroll
                    for (int cc = 0; cc < 8; ++cc) acc8[cc] += pw[cc * 128 + e] * w; }
                v4u o; o.x = pk2(acc8[0], acc8[1]); o.y = pk2(acc8[2], acc8[3]); o.z = pk2(acc8[4], acc8[5]); o.w = pk2(acc8[6], acc8[7]);
                *(GAS v4u*)(Wcomb_t + (size_t)d * 512 + g * 128 + c8 * 8) = o;
            }
        }
        for (int e = ((hw * 64) + lane); e < M * 32; e += NHW * 64) {
            const int row = e >> 5, i = e & 31;
            const float inv = (float)exp2((double)(-i) * (13.287712379549449 / 32.0));
            const float ang = (float)a.pos[row] * inv;
            double rev = (double)ang * 0.15915494309189535; rev -= rint(rev);
            const float rr = (float)(rev * 6.283185307179586);
            cosT[e] = cosf(rr); sinT[e] = sinf(rr);
        }
        } else {
        for (int m = 2 * hw; m < M; m += 2 * NHW) {
            const GAS f32x4* xr = (const GAS f32x4*)(a.x + (size_t)m * DM) + lane; const GAS f32x4* gr = (const GAS f32x4*)a.g_mix + lane;
            f32x4 v[2][4]; float s2[2] = {0.f, 0.f};
#pragma unroll
            for (int r = 0; r < 2; ++r)
#pragma unroll
                for (int j = 0; j < 4; ++j) v[r][j] = xr[r * 256 + 64 * j];
#pragma unroll
            for (int r = 0; r < 2; ++r)
#pragma unroll
                for (int j = 0; j < 4; ++j) s2[r] += (v[r][j].x * v[r][j].x + v[r][j].y * v[r][j].y) + (v[r][j].z * v[r][j].z + v[r][j].w * v[r][j].w);
#pragma unroll
            for (int r = 0; r < 2; ++r) { const float rms = sqrtf(wave_sum(s2[r]) * (1.f / DM) + EPS), rstd = 1.0f / rms; if (lane == 0) rms0[m + r] = rms;
                GAS unsigned long long* o8 = (GAS unsigned long long*)(XN + (size_t)(m + r) * DM) + lane;
#pragma unroll
                for (int j = 0; j < 4; ++j) { const f32x4 g = gr[64 * j]; o8[64 * j] = (unsigned long long)pk2(v[r][j].x * rstd * g.x, v[r][j].y * rstd * g.y) | ((unsigned long long)pk2(v[r][j].z * rstd * g.z, v[r][j].w * rstd * g.w) << 32); } }
        }
        }
    }
    SEAM(0);
    if (IN(1)) {
        pg8::Gemm g{XN, Win_t, M, NZ, DM}; pg8::StaticOrder S; S.init(M, NZ, G, bx);
        pg8::EpiZ E{U, CQ, CKV, KR, GA, GB, ssq_q, ssq_kv, a.b_gate, cosT, sinT};
        pg8::gemm_phase<pg8::EpiZ, pg8::StaticOrder, true, true>(ring, g, S, E);
    }
    SEAM(1);
    if (IN(2)) {
#if !defined(SUBP) || SUBP==0
        {
            const int w = 2 << (lane >> 4);
            for (int run = gw; run < M / 32; run += NGW) {
                const int r0 = run * 32, s0 = r0 & (SEQ - 1);
                const bf16* up = U + (size_t)r0 * 512 + lane * 8;
                float sum[8] = {0.f, 0.f, 0.f, 0.f, 0.f, 0.f, 0.f, 0.f};
                for (int j = 1; j < 16; ++j) if (j < w && s0 - j >= 0) { const v4u q = *(const v4u*)(up - (size_t)j * 512);
                    sum[0] += bflo(q.x); sum[1] += bfhi(q.x); sum[2] += bflo(q.y); sum[3] += bfhi(q.y); sum[4] += bflo(q.z); sum[5] += bfhi(q.z); sum[6] += bflo(q.w); sum[7] += bfhi(q.w); }
                for (int tb = 0; tb < 32; tb += 4) {
                    v4u q4[4], p4[4];
#pragma unroll
                    for (int j = 0; j < 4; ++j) { q4[j] = *(const v4u*)(up + (size_t)(tb + j) * 512);
                        p4[j] = (s0 + tb + j - (w - 1) >= 0) ? *(const v4u*)(up + (ptrdiff_t)(tb + j - (w - 1)) * 512) : (v4u){0u, 0u, 0u, 0u}; }
                    __builtin_amdgcn_sched_barrier(0);
#pragma unroll
                    for (int j = 0; j < 4; ++j) { const int t = tb + j; const v4u q = q4[j], p = p4[j];
                        const float c[8] = {bflo(q.x), bfhi(q.x), bflo(q.y), bfhi(q.y), bflo(q.z), bfhi(q.z), bflo(q.w), bfhi(q.w)};
                        const int cnt = (s0 + t + 1) < w ? (s0 + t + 1) : w; const float ic = 1.0f / (float)cnt;
                        float o[8];
#pragma unroll
                        for (int k = 0; k < 8; ++k) { sum[k] += c[k]; o[k] = sum[k] * ic - c[k]; }
                        v4u ov; ov.x = pk2(o[0], o[1]); ov.y = pk2(o[2], o[3]); ov.z = pk2(o[4], o[5]); ov.w = pk2(o[6], o[7]);
                        *(v4u*)(POOLED + (size_t)(r0 + t) * 512 + lane * 8) = ov;
                        sum[0] -= bflo(p.x); sum[1] -= bfhi(p.x); sum[2] -= bflo(p.y); sum[3] -= bfhi(p.y); sum[4] -= bflo(p.z); sum[5] -= bfhi(p.z); sum[6] -= bflo(p.w); sum[7] -= bfhi(p.w); }
                }
            }
        }
#endif
#if !defined(SUBP) || SUBP==1
        { pg8::Gemm g{CQ, Wuq_t, M, 1536, 256}; pg8::StaticOrder S; S.init(M, 1536, G, bx);
          pg8::EpiQ E{Qb, ssq_q, cosT, sinT};
          pg8::gemm_phase<pg8::EpiQ, pg8::StaticOrder, true, true>(ring, g, S, E); }
#endif
        {
            const float* ssq = ssq_kv;
            for (int r4 = gw; r4 < M / 4; r4 += NGW) { const int row = r4 * 4 + (lane >> 4), c = (lane & 15) * 8;
                const float rs = 1.0f / sqrtf(ssq[row] * (1.0f / 128.0f) + EPS);
                const v4u q = *(const v4u*)(CKV + (size_t)row * 128 + c);
                v4u o; o.x = pk2(bflo(q.x) * rs, bfhi(q.x) * rs); o.y = pk2(bflo(q.y) * rs, bfhi(q.y) * rs); o.z = pk2(bflo(q.z) * rs, bfhi(q.z) * rs); o.w = pk2(bflo(q.w) * rs, bfhi(q.w) * rs);
                *(v4u*)(LAT + (size_t)row * 128 + c) = o; }
        }
    }
    SEAM(2);
    if (IN(3)) {
        { pg8::Gemm g{POOLED, Wcomb_t, M, DM, 512}; pg8::StaticOrder S; S.init(M, DM, G, bx);
          pg8::EpiGate<0> E{GA, nullptr};
          pg8::gemm_phase<pg8::EpiGate<0>, pg8::StaticOrder, true, true>(ring, g, S, E); }
        __syncthreads();
#ifdef PROBE_ATT2
        for (int rep_ = 0; rep_ < 2; ++rep_) { __syncthreads();
#endif
        att::attn_phase((char*)lds, Qb, LAT, KR, LAT, Ob, vcu, G, BATCH * att::NH * 8);
#ifdef PROBE_ATT2
        }
#endif
    }
    SEAM(3);
    if (IN(4)) {
        pg8::Gemm g{Ob, Watt_t, M, DM, DM}; pg8::StaticOrder S; S.init(M, DM, G, bx);
        pg8::EpiGate<1> E{GA, GB};
        pg8::gemm_phase<pg8::EpiGate<1>, pg8::StaticOrder, true, true>(ring, g, S, E);
    }
    SEAM(4);
    if (IN(5)) {
        pg8::Gemm g{GA, Wout_t, M, DM, DM}; pg8::StaticOrder S; S.init(M, DM, G, bx);
        pg8::EpiRes<true, true> E{XN, X1B, ssq1, nullptr, rms0, a.g_mix};
        pg8::gemm_phase<pg8::EpiRes<true, true>, pg8::StaticOrder, true, true>(ring, g, S, E);
    }
    SEAM(5);
    if (IN(6)) {
        pg8::Gemm g{X1B, W1_t, M, FF, DM}; pg8::StaticOrder S; S.init(M, FF, G, bx);
        pg8::EpiMlpIn E{Hb};
        pg8::gemm_phase<pg8::EpiMlpIn, pg8::StaticOrder, true, true>(ring, g, S, E);
#ifdef PROBE_MLP2
        pg8::gemm_phase<pg8::EpiMlpIn, pg8::StaticOrder, true, true>(ring, g, S, E);
#endif
    }
    SEAM(6);
    if (IN(7)) {
        pg8::Gemm g{Hb, W2_t, M, DM, FF}; pg8::StaticOrder S; S.init(M, DM, G, bx);
        pg8::EpiStore E{X2B};
        pg8::gemm_phase<pg8::EpiStore, pg8::StaticOrder, true, true>(ring, g, S, E);
    }
    SEAM(7);
    if (IN(8)) {
        for (int m = 2 * gw; m < M; m += 2 * NGW) {
            const GAS f32x4* gr = (const GAS f32x4*)a.g_final + 2 * lane; v4u qx[2][2], qd[2][2]; float s1[2];
#pragma unroll
            for (int r = 0; r < 2; ++r) { s1[r] = ssq1[m + r];
#pragma unroll
                for (int j = 0; j < 2; ++j) { qx[r][j] = *(const GAS v4u*)(X1B + (size_t)(m + r) * DM + 8 * lane + 512 * j); qd[r][j] = *(const GAS v4u*)(X2B + (size_t)(m + r) * DM + 8 * lane + 512 * j); } }
#pragma unroll
            for (int r = 0; r < 2; ++r) { const float r2 = 1.0f / (s1[r] * (1.f / DM) + EPS); f32x4 v[2][2]; float s2 = 0.f;
#pragma unroll
                for (int j = 0; j < 2; ++j) { const v4u x = qx[r][j], d = qd[r][j];
                    v[j][0] = (f32x4){bflo(x.x), bfhi(x.x), bflo(x.y), bfhi(x.y)} + (f32x4){bflo(d.x), bfhi(d.x), bflo(d.y), bfhi(d.y)} * r2;
                    v[j][1] = (f32x4){bflo(x.z), bfhi(x.z), bflo(x.w), bfhi(x.w)} + (f32x4){bflo(d.z), bfhi(d.z), bflo(d.w), bfhi(d.w)} * r2;
#pragma unroll
                    for (int h = 0; h < 2; ++h) s2 += (v[j][h].x * v[j][h].x + v[j][h].y * v[j][h].y) + (v[j][h].z * v[j][h].z + v[j][h].w * v[j][h].w); }
                const float rs = 1.0f / sqrtf(wave_sum(s2) * (1.f / DM) + EPS); GAS f32x4* xr = (GAS f32x4*)(a.out + (size_t)(m + r) * DM) + 2 * lane;
#pragma unroll
                for (int j = 0; j < 2; ++j) { xr[128 * j] = v[j][0] * rs * gr[128 * j]; xr[128 * j + 1] = v[j][1] * rs * gr[128 * j + 1]; } }
        }
    }
#undef IN
#undef SEAM
}
#ifdef DEBUG_CHECK
namespace dbg {
__device__ __forceinline__ float bf2f(bf16 v) { return __uint_as_float((unsigned)v << 16); }
__device__ __forceinline__ float rbf(float f) { return __uint_as_float(f2bf(f) << 16); }
__device__ __forceinline__ bool bad(float got, float ref) { return !(fabsf(got - ref) <= 0.03f * fabsf(ref) + 0.03f); }
__device__ __forceinline__ int srow(int s) { const int sp[8] = {0, 1, 255, 256, 4095, 4096, 4097, 65535}; return s < 8 ? (s == 0 ? 0 : s == 1 ? 1 : s == 2 ? 255 : s == 3 ? 256 : s == 4 ? 4095 : s == 5 ? 4096 : s == 6 ? 4097 : 65535) : (int)(((unsigned)s * 2654435761u) >> 16); }
__device__ __forceinline__ void fail(unsigned* flags, int idx) { atomicOr(flags + idx, 1u); }
__device__ float xrstd(const Args& a, int row) { float s = 0.f; for (int k = 0; k < 1024; ++k) { const float v = a.x[(size_t)row * 1024 + k]; s += v * v; } return 1.0f / sqrtf(s / 1024.f + 1e-6f); }
__device__ float zcol(const Args& a, int row, float rstd, int src) { float s = 0.f; for (int k = 0; k < 1024; ++k) s += rbf(a.x[(size_t)row * 1024 + k] * rstd * a.g_mix[k]) * rbf(a.w_in[(size_t)k * 3008 + src]); return s; }
__device__ void cs(const Args& a, int row, int i, float& c, float& s) { const float inv = powf(10000.f, -(float)i / 32.f); const float ang = (float)a.pos[row] * inv; c = cosf(ang); s = sinf(ang); }

__global__ void chk1(Args a) {
    unsigned* flags = (unsigned*)a.ws; unsigned char* ws = a.ws; const int s = blockIdx.x * blockDim.x + threadIdx.x, row = srow(s);
    const bf16 *U = (bf16*)(ws + WS_U), *CQ = (bf16*)(ws + WS_CQ), *CKV = (bf16*)(ws + WS_CKV), *KR = (bf16*)(ws + WS_KR), *GA = (bf16*)(ws + WS_GA), *GB = (bf16*)(ws + WS_GB);
    const float* ssq_q = (const float*)(ws + WS_SSQ); const float* ssq_kv = ssq_q + M;
    const float rstd = xrstd(a, row);
    const int cu = (s * 37) % 512, cq = (s * 29) % 256, ck = (s * 17) % 128, j = (s * 7) % 64, cg = (s * 101) % 1024;
    if (bad(bf2f(U[(size_t)row * 512 + cu]), zcol(a, row, rstd, cu))) fail(flags, 1);
    if (bad(bf2f(CQ[(size_t)row * 256 + cq]), zcol(a, row, rstd, 512 + cq))) fail(flags, 1);
    if (bad(bf2f(CKV[(size_t)row * 128 + ck]), zcol(a, row, rstd, 768 + ck))) fail(flags, 1);
    { const int i = j & 31; float c, sn; cs(a, row, i, c, sn); const float x1 = zcol(a, row, rstd, 896 + i), x2 = zcol(a, row, rstd, 928 + i);
      const float ref = j < 32 ? x1 * c - x2 * sn : x2 * c + x1 * sn; if (bad(bf2f(KR[(size_t)row * 64 + j]), ref)) fail(flags, 2); }
    { const float za = zcol(a, row, rstd, 960 + cg) + a.b_gate[cg], zb = zcol(a, row, rstd, 1984 + cg) + a.b_gate[1024 + cg];
      if (bad(bf2f(GA[(size_t)row * 1024 + cg]), 1.f / (1.f + expf(-za)))) { fail(flags, 3); atomicMax(flags + 32, __float_as_uint(fabsf(bf2f(GA[(size_t)row * 1024 + cg]) - za))); atomicAdd(flags + 33, 1u); }
      if (bad(bf2f(GB[(size_t)row * 1024 + cg]), 1.f / (1.f + expf(-zb)))) fail(flags, 18);
      const bf16* Win_t = (const bf16*)(ws + WS_WIN); const int kk = (s * 3) % 1024, jj = 1024 + cg;
      if (bad(bf2f(Win_t[(size_t)jj * 1024 + kk]) * 100.f, rbf(a.w_in[(size_t)kk * 3008 + jj - 64]) * 100.f)) fail(flags, 17);
      const int j2 = 2048 + cg; if (bad(bf2f(Win_t[(size_t)j2 * 1024 + kk]) * 100.f, rbf(a.w_in[(size_t)kk * 3008 + j2 - 64]) * 100.f)) fail(flags, 19); }
    { float q = 0.f, k = 0.f; for (int c = 0; c < 256; ++c) { const float v = bf2f(CQ[(size_t)row * 256 + c]); q += v * v; } for (int c = 0; c < 128; ++c) { const float v = bf2f(CKV[(size_t)row * 128 + c]); k += v * v; }
      if (bad(ssq_q[row], q) || bad(ssq_kv[row], k)) fail(flags, 4); }
}
__global__ void chk2(Args a) {
    unsigned* flags = (unsigned*)a.ws; unsigned char* ws = a.ws; const int s = blockIdx.x * blockDim.x + threadIdx.x, row = srow(s);
    const bf16 *U = (bf16*)(ws + WS_U), *CQ = (bf16*)(ws + WS_CQ), *CKV = (bf16*)(ws + WS_CKV), *Qb = (bf16*)(ws + WS_Q), *KN = (bf16*)(ws + WS_KN), *Vb = (bf16*)(ws + WS_XN), *POOLED = (bf16*)(ws + WS_POOLED);
    float q = 0.f, k = 0.f; for (int c = 0; c < 256; ++c) { const float v = bf2f(CQ[(size_t)row * 256 + c]); q += v * v; } for (int c = 0; c < 128; ++c) { const float v = bf2f(CKV[(size_t)row * 128 + c]); k += v * v; }
    const float rq = 1.0f / sqrtf(q / 256.f + 1e-6f), rk = 1.0f / sqrtf(k / 128.f + 1e-6f);
    const int h = s & 7, d = (s * 13) % 128, i = (s * 5) % 32;
#define QCOL(col) ({ float acc_ = 0.f; for (int kk = 0; kk < 256; ++kk) acc_ += bf2f(CQ[(size_t)row * 256 + kk]) * rbf(a.g_q[kk] * a.w_uq[(size_t)kk * 1536 + (col)]); acc_ * rq; })
#define KVCOL(col) ({ float acc_ = 0.f; for (int kk = 0; kk < 128; ++kk) acc_ += bf2f(CKV[(size_t)row * 128 + kk]) * rbf(a.g_kv[kk] * a.w_ukv[(size_t)kk * 2048 + (col)]); acc_ * rk; })
    if (bad(bf2f(Qb[(size_t)row * 1536 + h * 192 + d]), QCOL(h * 192 + d))) fail(flags, 5);
    { float c, sn; cs(a, row, i, c, sn); const float x1 = QCOL(h * 192 + 128 + i), x2 = QCOL(h * 192 + 160 + i);
      if (bad(bf2f(Qb[(size_t)row * 1536 + h * 192 + 128 + i]), x1 * c - x2 * sn) || bad(bf2f(Qb[(size_t)row * 1536 + h * 192 + 160 + i]), x2 * c + x1 * sn)) fail(flags, 6); }
    if (bad(bf2f(KN[(size_t)row * 1024 + h * 128 + d]), KVCOL(h * 256 + d)) || bad(bf2f(Vb[(size_t)row * 1024 + h * 128 + d]), KVCOL(h * 256 + 128 + d))) fail(flags, 7);
    { const int c = (s * 37) % 512, w = 2 << (c >> 7), t = row & 4095; float sum = 0.f; int cnt = 0; for (int jj = 0; jj < w; ++jj) if (t - jj >= 0) { sum += bf2f(U[(size_t)(row - jj) * 512 + c]); ++cnt; }
      if (bad(bf2f(POOLED[(size_t)row * 512 + c]), sum / cnt - bf2f(U[(size_t)row * 512 + c]))) fail(flags, 8); }
#undef QCOL
#undef KVCOL
}
__device__ float ya_naive(const Args& a, int row, int col, const bf16* POOLED) {
    const float rstd = xrstd(a, row); const float ga = 1.f / (1.f + expf(-(zcol(a, row, rstd, 960 + col) + a.b_gate[col])));
    float acc = 0.f;
    for (int c = 0; c < 512; ++c) { const int g = c >> 7; float w = 0.f; for (int e = 0; e < 128; ++e) w += a.pool_w[(size_t)c * 128 + e] * a.pool_scale[g * 128 + e] * a.w_pool_proj[(size_t)(g * 128 + e) * 1024 + col]; acc += bf2f(POOLED[(size_t)row * 512 + c]) * rbf(w); }
    return ga * acc;
}
__global__ void chk3(Args a) {
    unsigned* flags = (unsigned*)a.ws; unsigned char* ws = a.ws; const int s = blockIdx.x * blockDim.x + threadIdx.x, row = srow(s);
    const bf16 *Qb = (bf16*)(ws + WS_Q), *KN = (bf16*)(ws + WS_KN), *KR = (bf16*)(ws + WS_KR), *Vb = (bf16*)(ws + WS_XN), *Ob = (bf16*)(ws + WS_O), *POOLED = (bf16*)(ws + WS_POOLED), *GA = (bf16*)(ws + WS_GA);
    const int h = s & 7, d = (s * 13) % 128, t = row & 4095, r0 = row - t;
    float mx = -1e30f;
    for (int key = 0; key <= t; ++key) { float sc = 0.f; for (int e = 0; e < 128; ++e) sc += bf2f(Qb[(size_t)row * 1536 + h * 192 + e]) * bf2f(KN[(size_t)(r0 + key) * 1024 + h * 128 + e]);
        for (int e = 0; e < 64; ++e) sc += bf2f(Qb[(size_t)row * 1536 + h * 192 + 128 + e]) * bf2f(KR[(size_t)(r0 + key) * 64 + e]); sc *= 0.07216878364870322f; mx = fmaxf(mx, sc); }
    float l = 0.f, o = 0.f;
    for (int key = 0; key <= t; ++key) { float sc = 0.f; for (int e = 0; e < 128; ++e) sc += bf2f(Qb[(size_t)row * 1536 + h * 192 + e]) * bf2f(KN[(size_t)(r0 + key) * 1024 + h * 128 + e]);
        for (int e = 0; e < 64; ++e) sc += bf2f(Qb[(size_t)row * 1536 + h * 192 + 128 + e]) * bf2f(KR[(size_t)(r0 + key) * 64 + e]); sc *= 0.07216878364870322f; const float p = expf(sc - mx); l += p; o += p * bf2f(Vb[(size_t)(r0 + key) * 1024 + h * 128 + d]); }
    if (bad(bf2f(Ob[(size_t)row * 1024 + h * 128 + d]), o / l)) fail(flags, 9);
    const int col = (s * 101) % 1024;
    if (bad(bf2f(GA[(size_t)row * 1024 + col]), ya_naive(a, row, col, POOLED))) fail(flags, 10);
}
__global__ void chk4(Args a) {
    unsigned* flags = (unsigned*)a.ws; unsigned char* ws = a.ws; const int s = blockIdx.x * blockDim.x + threadIdx.x, row = srow(s);
    const bf16 *Ob = (bf16*)(ws + WS_O), *POOLED = (bf16*)(ws + WS_POOLED), *GA = (bf16*)(ws + WS_GA);
    const int col = (s * 101) % 1024; const float rstd = xrstd(a, row);
    const float gb = 1.f / (1.f + expf(-(zcol(a, row, rstd, 1984 + col) + a.b_gate[1024 + col])));
    float bm = 0.f; for (int k = 0; k < 1024; ++k) bm += bf2f(Ob[(size_t)row * 1024 + k]) * rbf(a.w_attn[(size_t)k * 1024 + col]);
    if (bad(bf2f(GA[(size_t)row * 1024 + col]), ya_naive(a, row, col, POOLED) + gb * bm)) fail(flags, 11);
}
__global__ void chk5(Args a) {
    unsigned* flags = (unsigned*)a.ws; unsigned char* ws = a.ws; const int s = blockIdx.x * blockDim.x + threadIdx.x, row = srow(s);
    const bf16 *Y = (bf16*)(ws + WS_GA), *X1B = (bf16*)(ws + WS_XN); const float* ssq1 = (const float*)(ws + WS_SSQ) + 2 * M;
    const int col = (s * 101) % 1024;
    float acc = 0.f; for (int k = 0; k < 1024; ++k) acc += bf2f(Y[(size_t)row * 1024 + k]) * rbf(a.w_out[(size_t)k * 1024 + col]);
    const float ref = a.x[(size_t)row * 1024 + col] + acc;
    if (bad(a.out[(size_t)row * 1024 + col], ref) || bad(bf2f(X1B[(size_t)row * 1024 + col]), ref)) fail(flags, 12);
    float q = 0.f; for (int c = 0; c < 1024; ++c) { const float v = a.out[(size_t)row * 1024 + c]; q += v * v; }
    if (bad(ssq1[row], q)) fail(flags, 13);
}
__global__ void chk6(Args a) {
    unsigned* flags = (unsigned*)a.ws; unsigned char* ws = a.ws; const int s = blockIdx.x * blockDim.x + threadIdx.x, row = srow(s);
    const bf16 *X1B = (bf16*)(ws + WS_XN), *Hb = (bf16*)(ws + WS_H); const float* ssq1 = (const float*)(ws + WS_SSQ) + 2 * M;
    const int col = (s * 401) % 4096; const float rs = 1.0f / sqrtf(ssq1[row] / 1024.f + 1e-6f);
    float acc = 0.f; for (int k = 0; k < 1024; ++k) acc += bf2f(X1B[(size_t)row * 1024 + k]) * rbf(a.g_mlp[k] * a.w1[(size_t)k * 4096 + col]);
    const float v = fmaxf(acc * rs, 0.f);
    if (bad(bf2f(Hb[(size_t)row * 4096 + col]), v * v)) fail(flags, 14);
}
__global__ void chk7(Args a) {
    unsigned* flags = (unsigned*)a.ws; unsigned char* ws = a.ws; const int s = blockIdx.x * blockDim.x + threadIdx.x, row = srow(s);
    const bf16 *X1B = (bf16*)(ws + WS_XN), *Hb = (bf16*)(ws + WS_H); const float* ssq2 = (const float*)(ws + WS_SSQ) + 3 * M;
    const int col = (s * 101) % 1024;
    float acc = 0.f; for (int k = 0; k < 4096; ++k) acc += bf2f(Hb[(size_t)row * 4096 + k]) * rbf(a.w2[(size_t)k * 1024 + col]);
    if (bad(a.out[(size_t)row * 1024 + col], bf2f(X1B[(size_t)row * 1024 + col]) + acc)) fail(flags, 15);
    float q = 0.f; for (int c = 0; c < 1024; ++c) { const float v = a.out[(size_t)row * 1024 + c]; q += v * v; }
    if (bad(ssq2[row], q)) fail(flags, 16);
}
__global__ void chk_final(Args a) { const unsigned* flags = (const unsigned*)a.ws; const int order[19] = {17, 19, 1, 2, 3, 18, 4, 5, 6, 7, 8, 9, 10, 11, 12, 13, 14, 15, 16}; int first = 0; for (int i = 0; i < 19; ++i) if (flags[order[i]] && !first) first = order[i]; if (first) a.out[0] += 1000.f * first; a.out[1] += 1e6f * __uint_as_float(flags[32]); }
}
#endif
constexpr int N_PHASES = 9;

extern "C" void kernel_launch(void* const* d_in, const int* in_sizes, int n_in, void* d_out, int out_size, void* d_ws, size_t ws_size, hipStream_t stream) {
    static int grid = 0;
    if (grid == 0) {
        if (n_in != 18 || in_sizes[0] != M * DM || out_size != M * DM || ws_size < WS_END) { fprintf(stderr, "kernel_launch: unexpected shapes (n_in %d, in0 %d, out %d, ws %zu)\n", n_in, n_in > 0 ? in_sizes[0] : -1, out_size, ws_size); grid = -1; return; }
        int dev = 0, cus = 0, per_cu = 0;
        if (hipGetDevice(&dev) != hipSuccess || hipDeviceGetAttribute(&cus, hipDeviceAttributeMultiprocessorCount, dev) != hipSuccess) { grid = -1; return; }
        if (hipFuncSetAttribute((const void*)mk_fwd, hipFuncAttributeMaxDynamicSharedMemorySize, LDS_BYTES) != hipSuccess) { fprintf(stderr, "kernel_launch: hipFuncSetAttribute failed\n"); grid = -1; return; }
        if (hipOccupancyMaxActiveBlocksPerMultiprocessor(&per_cu, (const void*)mk_fwd, NWAVES * 64, LDS_BYTES) != hipSuccess || per_cu < 1) { fprintf(stderr, "kernel_launch: occupancy query says %d\n", per_cu); per_cu = 1; }
        (void)hipGetLastError();
        grid = cus * (per_cu > 1 ? 1 : per_cu);
    }
    if (grid < 0) return;
#ifdef DEBUG_CHECK
    (void)hipMemsetAsync((char*)d_ws, 0, 4096, stream);
    (void)hipMemsetAsync((char*)d_ws + WS_GA, 0x40, 128 * MiB, stream);
#endif
    (void)hipMemsetAsync((char*)d_ws, 0, WS_SSQ + (size_t)4 * M * sizeof(float), stream);
    Args a{};
    a.x = (const float*)d_in[0]; a.pos = (const int*)d_in[1]; a.g_mix = (const float*)d_in[2]; a.w_in = (const float*)d_in[3]; a.b_gate = (const float*)d_in[4];
    a.pool_w = (const float*)d_in[5]; a.pool_scale = (const float*)d_in[6]; a.w_pool_proj = (const float*)d_in[7]; a.g_q = (const float*)d_in[8]; a.w_uq = (const float*)d_in[9];
    a.g_kv = (const float*)d_in[10]; a.w_ukv = (const float*)d_in[11]; a.w_attn = (const float*)d_in[12]; a.w_out = (const float*)d_in[13]; a.g_mlp = (const float*)d_in[14];
    a.w1 = (const float*)d_in[15]; a.w2 = (const float*)d_in[16]; a.g_final = (const float*)d_in[17];
    a.out = (float*)d_out; a.ws = (unsigned char*)d_ws;
#if MK_LAUNCHES == 1
    a.ph_lo = 0; a.ph_hi = N_PHASES;
    void* args[] = {&a};
    hipError_t e = hipLaunchCooperativeKernel((const void*)mk_fwd, dim3(grid), dim3(NWAVES * 64), args, LDS_BYTES, stream);
    if (e != hipSuccess) fprintf(stderr, "kernel_launch: cooperative launch failed: %s (grid %d)\n", hipGetErrorString(e), grid);
#else
    for (int p = 0; p < N_PHASES; ++p) { a.ph_lo = p; a.ph_hi = p + 1; hipLaunchKernelGGL(mk_fwd, dim3(grid), dim3(NWAVES * 64), LDS_BYTES, stream, a);
#ifdef DEBUG_CHECK
        if (p == 1) hipLaunchKernelGGL(dbg::chk1, dim3(1), dim3(64), 0, stream, a);
        if (p == 2) hipLaunchKernelGGL(dbg::chk2, dim3(1), dim3(64), 0, stream, a);
        if (p == 3) hipLaunchKernelGGL(dbg::chk3, dim3(1), dim3(64), 0, stream, a);
        if (p == 4) hipLaunchKernelGGL(dbg::chk4, dim3(1), dim3(64), 0, stream, a);
        if (p == 5) hipLaunchKernelGGL(dbg::chk5, dim3(1), dim3(64), 0, stream, a);
        if (p == 6) hipLaunchKernelGGL(dbg::chk6, dim3(1), dim3(64), 0, stream, a);
        if (p == 7) hipLaunchKernelGGL(dbg::chk7, dim3(1), dim3(64), 0, stream, a);
        if (p == 8) hipLaunchKernelGGL(dbg::chk_final, dim3(1), dim3(1), 0, stream, a);
#endif
    }
#endif
}
```

```cpp
#include <hip/hip_runtime.h>
#include <hip/hip_bf16.h>
#include <hip/hip_cooperative_groups.h>
#include <cstdio>
#include <cstdint>
#include <cmath>
namespace cg = cooperative_groups;
namespace pg8 {
#define PG8_LAS __attribute__((address_space(3)))
typedef unsigned short bf16_t;
typedef short bf16x8 __attribute__((ext_vector_type(8)));
typedef float f32x4 __attribute__((ext_vector_type(4)));
typedef unsigned u32x4 __attribute__((ext_vector_type(4)));
constexpr int BM = 256, BK = 64, HALF = 128, HTB = HALF * BK * 2  , STAGE_BYTES = 8 * HTB, NXCD = 8, WGM = 8;

__host__ __device__ __forceinline__ int lds_byte(int r, int c) { const int st = (r >> 4) * 2 + (c >> 5), rr = r & 15, cc = c & 31, ob = rr * 64 + cc * 2; return st * 1024 + (ob ^ (((ob >> 9) & 1) << 5)); }
__host__ __device__ __forceinline__ void stage_rc(int b, int& R, int& C) { const int st = b / 1024, sb = b % 1024, swz = sb ^ (((sb >> 9) & 1) << 5); R = (st >> 1) * 16 + swz / 64; C = (st & 1) * 32 + (swz % 64) / 2; }
__host__ __device__ __forceinline__ int perm32(int rho) { const int n = rho >> 4, i = rho & 15; return 8 * (i >> 2) + 4 * n + (i & 3); }

struct Unit { int pm, pn; };
struct Gemm { const bf16_t* A; const bf16_t* Bt; int M, N, K; };

struct StaticOrder {
    int nM, nN, nwg, G, c;
    __host__ __device__ void init(int M, int N, int G_, int c_) { nM = M / BM; nN = N / BM; nwg = nM * nN; G = G_; c = c_; }
    __host__ __device__ bool next(int i, Unit& u) const {
        const long L = (long)i * G + c; if (L >= nwg) return false;
        int wgid = (int)L; { const int q = nwg / NXCD, r = nwg % NXCD, xcd = wgid % NXCD, off = wgid / NXCD; wgid = (xcd < r ? xcd * (q + 1) : r * (q + 1) + (xcd - r) * q) + off; }
        const int nig = WGM * nN, gid = wgid / nig, fm = gid * WGM, gsz = (nM - fm) < WGM ? (nM - fm) : WGM;
        u.pm = fm + ((wgid % nig) % gsz); u.pn = (wgid % nig) / gsz; return true;
    }
    __device__ __forceinline__ void a_ready(const Unit&) const {}
    __device__ __forceinline__ void done(const Unit&) const {}
};

typedef float f32x2_cv __attribute__((ext_vector_type(2))); typedef __bf16 bf16x2_cv __attribute__((ext_vector_type(2)));
__device__ __forceinline__ unsigned cvt_pk_bf16(float lo, float hi) { f32x2_cv v = {lo, hi}; bf16x2_cv b = __builtin_convertvector(v, bf16x2_cv); return __builtin_bit_cast(unsigned, b); }
typedef float f32x2 __attribute__((ext_vector_type(2)));
constexpr float RMS_EPS = 1e-6f;
__device__ __forceinline__ u32x4 pack8(f32x4 a, f32x4 b) { u32x4 w; w.x = cvt_pk_bf16(a[0], a[1]); w.y = cvt_pk_bf16(a[2], a[3]); w.z = cvt_pk_bf16(b[0], b[1]); w.w = cvt_pk_bf16(b[2], b[3]); return w; }
__device__ __forceinline__ void unpack8(u32x4 w, f32x4& a, f32x4& b) {
    a[0] = __uint_as_float(w.x << 16); a[1] = __uint_as_float(w.x & 0xffff0000u); a[2] = __uint_as_float(w.y << 16); a[3] = __uint_as_float(w.y & 0xffff0000u);
    b[0] = __uint_as_float(w.z << 16); b[1] = __uint_as_float(w.z & 0xffff0000u); b[2] = __uint_as_float(w.w << 16); b[3] = __uint_as_float(w.w & 0xffff0000u); }
__device__ __forceinline__ float sumsq4(f32x4 v) { return (v[0] * v[0] + v[1] * v[1]) + (v[2] * v[2] + v[3] * v[3]); }
__device__ __forceinline__ float sigm(float v) { return __builtin_amdgcn_rcpf(1.0f + __builtin_amdgcn_exp2f(-1.4426950408889634f * v)); }
__device__ __forceinline__ f32x4 sigm4(f32x4 v) { return (f32x4){sigm(v[0]), sigm(v[1]), sigm(v[2]), sigm(v[3])}; }
typedef unsigned u32x2 __attribute__((ext_vector_type(2)));
__device__ __forceinline__ void rope_store(f32x4 v0, f32x4 v1, const float* cs, const float* sn, bf16_t* dst) {
    const f32x4 c = *(const f32x4*)cs, s = *(const f32x4*)sn;
    const f32x4 x1 = (f32x4){v0[0], v0[2], v1[0], v1[2]}, x2 = (f32x4){v0[1], v0[3], v1[1], v1[3]};
    const f32x4 o1 = x1 * c - x2 * s, o2 = x2 * c + x1 * s;
    u32x2 a, b; a.x = cvt_pk_bf16(o1[0], o1[1]); a.y = cvt_pk_bf16(o1[2], o1[3]); b.x = cvt_pk_bf16(o2[0], o2[1]); b.y = cvt_pk_bf16(o2[2], o2[3]);
    *(u32x2*)dst = a; *(u32x2*)(dst + 32) = b;
}
__device__ __forceinline__ void rope_store_r(f32x4 v0, f32x4 v1, f32x4 c, f32x4 sn, bf16_t* dst) {
    const f32x4 x1 = (f32x4){v0[0], v0[2], v1[0], v1[2]}, x2 = (f32x4){v0[1], v0[3], v1[1], v1[3]};
    const f32x4 o1 = x1 * c - x2 * sn, o2 = x2 * c + x1 * sn;
    u32x2 a, b; a.x = cvt_pk_bf16(o1[0], o1[1]); a.y = cvt_pk_bf16(o1[2], o1[3]); b.x = cvt_pk_bf16(o2[0], o2[1]); b.y = cvt_pk_bf16(o2[2], o2[3]);
    *(u32x2*)dst = a; *(u32x2*)(dst + 32) = b;
}
__device__ __forceinline__ unsigned q8(float v) { return (unsigned)(v * 255.0f + 0.5f); }
__device__ __forceinline__ u32x2 packg8(f32x4 a, f32x4 b) { u32x2 w; w.x = q8(a[0]) | (q8(a[1]) << 8) | (q8(a[2]) << 16) | (q8(a[3]) << 24); w.y = q8(b[0]) | (q8(b[1]) << 8) | (q8(b[2]) << 16) | (q8(b[3]) << 24); return w; }
__device__ __forceinline__ void unpackg8(u32x2 w, f32x4& a, f32x4& b) { const float k = 1.0f / 255.0f;
    a = (f32x4){(float)(w.x & 255u), (float)((w.x >> 8) & 255u), (float)((w.x >> 16) & 255u), (float)(w.x >> 24)} * k; b = (f32x4){(float)(w.y & 255u), (float)((w.y >> 8) & 255u), (float)((w.y >> 16) & 255u), (float)(w.y >> 24)} * k; }
#define EPI_ROWS_F(...) _Pragma("unroll") for (int ai = 0; ai < 2; ++ai) _Pragma("unroll") for (int m = 0; m < 4; ++m) { const int row = row0 + ai * HALF + m * 16; __VA_ARGS__ if (m & 1) asm volatile("" ::: "memory"); }
#define EPI_ROWS(...) _Pragma("unroll") for (int ai = 0; ai < 2; ++ai) _Pragma("unroll") for (int m = 0; m < 4; ++m) { const int row = row0 + ai * HALF + m * 16; __VA_ARGS__ }

struct EpiZ {
    static constexpr bool PERM = true, AFTER_DRAIN = false;
    bf16_t *U, *CQ, *CKV, *KR; unsigned char *GA, *GB; float *ssq_q, *ssq_kv; const float *bgate, *cosT, *sinT;
    __device__ __forceinline__ void operator()(const f32x4 (&acc)[2][2][4][2], const Unit& u, int wr, int wc, int fr, int fq) const {
        const int row0 = u.pm * BM + wr * 64 + fr, pn = u.pn, cl = wc * 32 + 8 * fq;
        if (pn < 2) {
            EPI_ROWS( _Pragma("unroll") for (int bj = 0; bj < 2; ++bj) *(u32x4*)(U + (size_t)row * 512 + pn * 256 + bj * HALF + cl) = pack8(acc[ai][bj][m][0], acc[ai][bj][m][1]); )
        } else if (pn == 2) {
            EPI_ROWS( float s = 0.f;
                _Pragma("unroll") for (int bj = 0; bj < 2; ++bj) { *(u32x4*)(CQ + (size_t)row * 256 + bj * HALF + cl) = pack8(acc[ai][bj][m][0], acc[ai][bj][m][1]); s += sumsq4(acc[ai][bj][m][0]) + sumsq4(acc[ai][bj][m][1]); }
                s += __shfl_xor(s, 16); s += __shfl_xor(s, 32); if (fq == 0) atomicAdd(ssq_q + row, s); )
        } else if (pn == 3) {
            const int i0 = 16 * (wc & 1) + 4 * fq;
#pragma unroll
            for (int ai = 0; ai < 2; ++ai) {
                f32x4 cs[4], sn[4];
                if (wc < 2) {
#pragma unroll
                    for (int m = 0; m < 4; ++m) { const size_t o_ = (size_t)(row0 + ai * HALF + m * 16) * 32 + i0; cs[m] = *(const f32x4*)(cosT + o_); sn[m] = *(const f32x4*)(sinT + o_); } }
                __builtin_amdgcn_sched_barrier(0);
#pragma unroll
                for (int m = 0; m < 4; ++m) { const int row = row0 + ai * HALF + m * 16;
                    float s = sumsq4(acc[ai][0][m][0]) + sumsq4(acc[ai][0][m][1]);
                    *(u32x4*)(CKV + (size_t)row * 128 + cl) = pack8(acc[ai][0][m][0], acc[ai][0][m][1]);
                    s += __shfl_xor(s, 16); s += __shfl_xor(s, 32); if (fq == 0) atomicAdd(ssq_kv + row, s);
                    if (wc < 2) rope_store_r(acc[ai][1][m][0], acc[ai][1][m][1], cs[m], sn[m], KR + (size_t)row * 64 + i0); }
                __builtin_amdgcn_sched_barrier(0);
            }
        } else {
            unsigned char* G = pn < 8 ? GA : GB; const int gc0 = (pn < 8 ? pn - 4 : pn - 8) * 256, bc0 = (pn - 4) * 256;
            f32x4 bv[2][2];
#pragma unroll
            for (int bj = 0; bj < 2; ++bj)
#pragma unroll
                for (int n = 0; n < 2; ++n) bv[bj][n] = *(const f32x4*)(bgate + bc0 + bj * HALF + cl + 4 * n);
            EPI_ROWS( _Pragma("unroll") for (int bj = 0; bj < 2; ++bj)
                *(u32x2*)(G + (size_t)row * 1024 + gc0 + bj * HALF + cl) = packg8(sigm4(acc[ai][bj][m][0] + bv[bj][0]), sigm4(acc[ai][bj][m][1] + bv[bj][1])); )
        }
    }
};
struct EpiQ {
    static constexpr bool PERM = true, AFTER_DRAIN = false;
    bf16_t* Q; const float* ssq_q; const float *cosT, *sinT;
    __device__ __forceinline__ void operator()(const f32x4 (&acc)[2][2][4][2], const Unit& u, int wr, int wc, int fr, int fq) const {
        const int row0 = u.pm * BM + wr * 64 + fr, pn = u.pn, cl = wc * 32 + 8 * fq;
        float rs[2][4];
#pragma unroll
        for (int ai = 0; ai < 2; ++ai)
#pragma unroll
            for (int m = 0; m < 4; ++m) rs[ai][m] = ssq_q[row0 + ai * HALF + m * 16];
        if (pn < 4) {
            __builtin_amdgcn_sched_barrier(0);
            EPI_ROWS( const float r_ = __builtin_amdgcn_rsqf(rs[ai][m] * (1.0f / 256.0f) + RMS_EPS);
                _Pragma("unroll") for (int bj = 0; bj < 2; ++bj) *(u32x4*)(Q + (size_t)row * 1536 + (2 * pn + bj) * 192 + cl) = pack8(acc[ai][bj][m][0] * r_, acc[ai][bj][m][1] * r_); )
        } else {
            const int i0 = 16 * (wc & 1) + 4 * fq;
#pragma unroll
            for (int ai = 0; ai < 2; ++ai) {
                f32x4 cs[4], sn[4];
#pragma unroll
                for (int m = 0; m < 4; ++m) { const size_t o_ = (size_t)(row0 + ai * HALF + m * 16) * 32 + i0; cs[m] = *(const f32x4*)(cosT + o_); sn[m] = *(const f32x4*)(sinT + o_); }
                __builtin_amdgcn_sched_barrier(0);
#pragma unroll
                for (int m = 0; m < 4; ++m) { const int row = row0 + ai * HALF + m * 16; const float r_ = __builtin_amdgcn_rsqf(rs[ai][m] * (1.0f / 256.0f) + RMS_EPS);
#pragma unroll
                    for (int bj = 0; bj < 2; ++bj) { const int h = 4 * (pn - 4) + 2 * bj + (wc >> 1);
                        rope_store_r(acc[ai][bj][m][0] * r_, acc[ai][bj][m][1] * r_, cs[m], sn[m], Q + (size_t)row * 1536 + h * 192 + 128 + i0); } }
                __builtin_amdgcn_sched_barrier(0);
            }
        }
    }
};
struct EpiKV {
    static constexpr bool PERM = true, AFTER_DRAIN = false;
    bf16_t *KN, *V; const float* ssq_kv;
    __device__ __forceinline__ void operator()(const f32x4 (&acc)[2][2][4][2], const Unit& u, int wr, int wc, int fr, int fq) const {
        const int row0 = u.pm * BM + wr * 64 + fr, cl = u.pn * 128 + wc * 32 + 8 * fq;
        EPI_ROWS_F( const float rs = __builtin_amdgcn_rsqf(ssq_kv[row] * (1.0f / 128.0f) + RMS_EPS);
            *(u32x4*)(KN + (size_t)row * 1024 + cl) = pack8(acc[ai][0][m][0] * rs, acc[ai][0][m][1] * rs);
            *(u32x4*)(V + (size_t)row * 1024 + cl) = pack8(acc[ai][1][m][0] * rs, acc[ai][1][m][1] * rs); )
    }
};
struct EpiGate2 {
    static constexpr bool PERM = true, AFTER_DRAIN = false;
    bf16_t* Y; const unsigned char *GA8, *GB8;
    __device__ __forceinline__ void operator()(const f32x4 (&acc)[2][2][4][2], const Unit& u, int wr, int wc, int fr, int fq) const {
        const int row0 = u.pm * BM + wr * 64 + fr, c0 = u.pn * 256 + wc * 32 + 8 * fq;
#pragma unroll
        for (int ai = 0; ai < 2; ++ai) {
            u32x4 yv[4][2]; u32x2 ga[4][2], gb[4][2];
#pragma unroll
            for (int m = 0; m < 4; ++m)
#pragma unroll
                for (int bj = 0; bj < 2; ++bj) { const size_t off = (size_t)(row0 + ai * HALF + m * 16) * 1024 + c0 + bj * HALF; yv[m][bj] = *(const u32x4*)(Y + off); ga[m][bj] = *(const u32x2*)(GA8 + off); gb[m][bj] = *(const u32x2*)(GB8 + off); }
            __builtin_amdgcn_sched_barrier(0);
#pragma unroll
            for (int m = 0; m < 4; ++m)
#pragma unroll
                for (int bj = 0; bj < 2; ++bj) { const size_t off = (size_t)(row0 + ai * HALF + m * 16) * 1024 + c0 + bj * HALF;
                    f32x4 a, b, g0, g1, h0, h1; unpack8(yv[m][bj], a, b); unpackg8(ga[m][bj], g0, g1); unpackg8(gb[m][bj], h0, h1);
                    *(u32x4*)(Y + off) = pack8(g0 * a + h0 * acc[ai][bj][m][0], g1 * b + h1 * acc[ai][bj][m][1]); }
            __builtin_amdgcn_sched_barrier(0);
        }
    }
};
template <bool BF, bool DN = false> struct EpiRes {
    static constexpr bool PERM = true, AFTER_DRAIN = false;
    const void* base; bf16_t* XB; float* ssq; const float* rsq; const float* rms0; const float* gdn;
    __device__ __forceinline__ void operator()(const f32x4 (&acc)[2][2][4][2], const Unit& u, int wr, int wc, int fr, int fq) const {
        const int row0 = u.pm * BM + wr * 64 + fr, c0 = u.pn * 256 + wc * 32 + 8 * fq;
        f32x4 gi[2][2];
        if (DN) {
#pragma unroll
            for (int bj = 0; bj < 2; ++bj)
#pragma unroll
                for (int n = 0; n < 2; ++n) { const f32x4 g = *(const f32x4*)(gdn + c0 + bj * HALF + 4 * n); gi[bj][n] = (f32x4){__builtin_amdgcn_rcpf(g[0]), __builtin_amdgcn_rcpf(g[1]), __builtin_amdgcn_rcpf(g[2]), __builtin_amdgcn_rcpf(g[3])}; } }
#pragma unroll
        for (int ai = 0; ai < 2; ++ai) {
            f32x4 xa[4][2], xb[4][2]; u32x4 xh[4][2]; float rq[4], rm[4];
#pragma unroll
            for (int m = 0; m < 4; ++m) { rq[m] = rsq ? rsq[row0 + ai * HALF + m * 16] : 0.f; rm[m] = DN ? rms0[row0 + ai * HALF + m * 16] : 1.f;
#pragma unroll
                for (int bj = 0; bj < 2; ++bj) { const size_t off = (size_t)(row0 + ai * HALF + m * 16) * 1024 + c0 + bj * HALF;
                    if (BF) xh[m][bj] = *(const u32x4*)((const bf16_t*)base + off); else { xa[m][bj] = *(const f32x4*)((const float*)base + off); xb[m][bj] = *(const f32x4*)((const float*)base + off + 4); } } }
            __builtin_amdgcn_sched_barrier(0);
#pragma unroll
            for (int m = 0; m < 4; ++m) { const int row = row0 + ai * HALF + m * 16; float s = 0.f; const float r2 = rsq ? __builtin_amdgcn_rcpf(rq[m] * (1.0f / 1024.0f) + RMS_EPS) : 1.0f;
#pragma unroll
                for (int bj = 0; bj < 2; ++bj) { const size_t off = (size_t)row * 1024 + c0 + bj * HALF;
                    f32x4 a, b; if (BF) unpack8(xh[m][bj], a, b); else { a = xa[m][bj]; b = xb[m][bj]; }
                    if (DN) { a = a * rm[m] * gi[bj][0]; b = b * rm[m] * gi[bj][1]; }
                    a = a + acc[ai][bj][m][0] * r2; b = b + acc[ai][bj][m][1] * r2; s += sumsq4(a) + sumsq4(b);
                    *(u32x4*)(XB + off) = pack8(a, b); }
                s += __shfl_xor(s, 16); s += __shfl_xor(s, 32); if (fq == 0) atomicAdd(ssq + row, s); }
            __builtin_amdgcn_sched_barrier(0);
        }
    }
};
struct EpiMlpIn {
    static constexpr bool PERM = true, AFTER_DRAIN = false;
    bf16_t* H;
    __device__ __forceinline__ void operator()(const f32x4 (&acc)[2][2][4][2], const Unit& u, int wr, int wc, int fr, int fq) const {
        const int row0 = u.pm * BM + wr * 64 + fr, c0 = u.pn * 256 + wc * 32 + 8 * fq;
        EPI_ROWS( _Pragma("unroll") for (int bj = 0; bj < 2; ++bj) { f32x4 a = acc[ai][bj][m][0], b = acc[ai][bj][m][1];
                a = __builtin_elementwise_max(a, (f32x4){0.f, 0.f, 0.f, 0.f}); b = __builtin_elementwise_max(b, (f32x4){0.f, 0.f, 0.f, 0.f});
                *(u32x4*)(H + (size_t)row * 4096 + c0 + bj * HALF) = pack8(a * a, b * b); } )
    }
};

struct EpiStore {
    static constexpr bool PERM = true, AFTER_DRAIN = false;
    bf16_t* D;
    __device__ __forceinline__ void operator()(const f32x4 (&acc)[2][2][4][2], const Unit& u, int wr, int wc, int fr, int fq) const {
        const int row0 = u.pm * BM + wr * 64 + fr, c0 = u.pn * 256 + wc * 32 + 8 * fq;
        EPI_ROWS( _Pragma("unroll") for (int bj = 0; bj < 2; ++bj) *(u32x4*)(D + (size_t)row * 1024 + c0 + bj * HALF) = pack8(acc[ai][bj][m][0], acc[ai][bj][m][1]); )
    }
};
template <class Epi, class Sched, bool ALIGN_EPI = false, bool SP2 = false>
__device__ __forceinline__ void gemm_phase(PG8_LAS unsigned char* lds, const Gemm g, const Sched& S, const Epi& E) {
    const int tid = threadIdx.x, wid = __builtin_amdgcn_readfirstlane(tid >> 6), lane = tid & 63, wr = wid >> 2, wc = wid & 3, fr = lane & 15, fq = lane >> 4;
    int K_ = g.K; asm volatile("" : "+s"(K_));
    const int K = K_, nt = K / BK;
    unsigned voffA[2], voffB[2];
#pragma unroll
    for (int i = 0; i < 2; ++i) { int R, C; stage_rc(tid * 16 + i * 8192, R, C); const int Rb = Epi::PERM ? ((R & ~31) + perm32(R & 31)) : R;
        voffA[i] = (unsigned)(R * K + C) * 2u; voffB[i] = (unsigned)(Rb * K + C) * 2u; }
    const size_t kstep = (size_t)(BK * 2);
    const size_t hstep = (size_t)HALF * K * 2;
    const size_t tstep = 2 * hstep;
    const unsigned ldsw = (unsigned)wid * 1024u;
    const int aoff = lds_byte(wr * 64 + fr, fq * 8), boff = lds_byte(wc * 32 + fr, fq * 8);
#define PG8_SA(b, h) (((b) * 2 + (h)) * HTB)
#define PG8_SB(b, h) ((4 + (b) * 2 + (h)) * HTB)
#define PG8_STAGE(bufoff, gbase, voff) do { _Pragma("unroll") for (int _i = 0; _i < 2; ++_i) \
        __builtin_amdgcn_global_load_lds((const unsigned*)((const char*)(gbase) + (voff)[_i]), (PG8_LAS unsigned*)(lds + (bufoff) + ldsw + _i * 8192), 16, 0, 0); } while (0)
#define PG8_LDA(dst, b, h) do { _Pragma("unroll") for (int m = 0; m < 4; ++m) _Pragma("unroll") for (int k = 0; k < 2; ++k) dst[m][k] = *(const PG8_LAS bf16x8*)(lds + PG8_SA(b, h) + aoff + m * 2048 + k * 1024); } while (0)
#define PG8_LDB(dst, b, h) do { _Pragma("unroll") for (int n = 0; n < 2; ++n) _Pragma("unroll") for (int k = 0; k < 2; ++k) dst[n][k] = *(const PG8_LAS bf16x8*)(lds + PG8_SB(b, h) + boff + n * 2048 + k * 1024); } while (0)
#define PG8_MMA(ai, bj, At, Bt) do { __builtin_amdgcn_s_setprio(1); _Pragma("unroll") for (int m = 0; m < 4; ++m) _Pragma("unroll") for (int n = 0; n < 2; ++n) _Pragma("unroll") for (int k = 0; k < 2; ++k) \
        acc[ai][bj][m][n] = __builtin_amdgcn_mfma_f32_16x16x32_bf16(Bt[n][k], At[m][k], acc[ai][bj][m][n], 0, 0, 0); __builtin_amdgcn_s_setprio(0); } while (0)
#define PG8_WAIT_V(n) asm volatile("s_waitcnt vmcnt(" #n ")" ::: "memory")
#define PG8_WAIT_L(n) asm volatile("s_waitcnt lgkmcnt(" #n ")" ::: "memory")
#define PG8_BAR __builtin_amdgcn_s_barrier()
#define PG8_SCHED __builtin_amdgcn_sched_barrier(0)
    Unit cur, nxt; int ui = 0;
    if (!S.next(0, cur)) return;
    f32x4 acc[2][2][4][2];
#pragma unroll
    for (int a = 0; a < 2; ++a)
#pragma unroll
        for (int b = 0; b < 2; ++b)
#pragma unroll
            for (int m = 0; m < 4; ++m)
#pragma unroll
                for (int n = 0; n < 2; ++n) acc[a][b][m][n] = (f32x4){0.f, 0.f, 0.f, 0.f};
    bf16x8 At[4][2], B0[2][2], B1[2][2];
    const char* cA = (const char*)g.A + (size_t)cur.pm * tstep; const char* cB = (const char*)g.Bt + (size_t)cur.pn * tstep;
    S.a_ready(cur);
    if constexpr (SP2) {
        PG8_STAGE(PG8_SB(0, 0), cB, voffB); PG8_STAGE(PG8_SB(0, 1), cB + hstep, voffB); PG8_STAGE(PG8_SA(0, 0), cA, voffA); PG8_STAGE(PG8_SA(0, 1), cA + hstep, voffA);
        if (wr == 1) PG8_BAR;
        PG8_WAIT_V(2); PG8_BAR;
        PG8_STAGE(PG8_SB(1, 0), cB + kstep, voffB); PG8_STAGE(PG8_SA(1, 0), cA + kstep, voffA); PG8_STAGE(PG8_SB(1, 1), cB + hstep + kstep, voffB);
        PG8_WAIT_V(6); PG8_BAR;
    } else {
        PG8_STAGE(PG8_SB(0, 0), cB, voffB); PG8_STAGE(PG8_SA(0, 0), cA, voffA); PG8_STAGE(PG8_SB(0, 1), cB + hstep, voffB); PG8_STAGE(PG8_SA(0, 1), cA + hstep, voffA);
        if (wr == 1) PG8_BAR;
        PG8_WAIT_V(4); PG8_BAR;
        PG8_STAGE(PG8_SB(1, 0), cB + kstep, voffB); PG8_STAGE(PG8_SA(1, 0), cA + kstep, voffA); PG8_STAGE(PG8_SB(1, 1), cB + hstep + kstep, voffB);
        PG8_WAIT_V(6); PG8_BAR;
    }
    for (;;) {
        const bool has_next = S.next(ui + 1, nxt);
        const char* nA = has_next ? (const char*)g.A + (size_t)nxt.pm * tstep : cA; const char* nB = has_next ? (const char*)g.Bt + (size_t)nxt.pn * tstep : cB;
        for (int t = 0; t < nt; t += 2) {
            const bool last = (t == nt - 2);
            const char* a1 = cA + (size_t)(t + 1) * kstep;
            const char* a2 = last ? nA : cA + (size_t)(t + 2) * kstep; const char* b2 = last ? nB : cB + (size_t)(t + 2) * kstep;
            const char* a3 = a2 + kstep; const char* b3 = b2 + kstep;
            if (last && has_next) S.a_ready(nxt);
            if constexpr (SP2) {
            PG8_LDB(B0, 0, 0); PG8_LDB(B1, 0, 1); PG8_SCHED; PG8_LDA(At, 0, 0); PG8_STAGE(PG8_SA(1, 1), a1 + hstep, voffA);
            PG8_WAIT_V(8); PG8_WAIT_L(0); PG8_BAR; PG8_MMA(0, 0, At, B0); PG8_MMA(0, 1, At, B1); PG8_BAR; PG8_SCHED;
            PG8_LDA(At, 0, 1); PG8_STAGE(PG8_SB(0, 0), b2, voffB); PG8_STAGE(PG8_SB(0, 1), b2 + hstep, voffB); PG8_STAGE(PG8_SA(0, 0), a2, voffA);
            PG8_WAIT_V(8); PG8_WAIT_L(0); PG8_BAR; PG8_MMA(1, 0, At, B0); PG8_MMA(1, 1, At, B1); PG8_BAR; PG8_SCHED;
            PG8_LDB(B0, 1, 0); PG8_LDB(B1, 1, 1); PG8_SCHED; PG8_LDA(At, 1, 0); PG8_STAGE(PG8_SA(0, 1), a2 + hstep, voffA);
            PG8_WAIT_V(8); PG8_WAIT_L(0); PG8_BAR; PG8_MMA(0, 0, At, B0); PG8_MMA(0, 1, At, B1); PG8_BAR; PG8_SCHED;
            PG8_LDA(At, 1, 1); PG8_STAGE(PG8_SB(1, 0), b3, voffB); PG8_STAGE(PG8_SB(1, 1), b3 + hstep, voffB); PG8_STAGE(PG8_SA(1, 0), a3, voffA);
            PG8_WAIT_V(8); PG8_WAIT_L(0); PG8_BAR; PG8_MMA(1, 0, At, B0); PG8_MMA(1, 1, At, B1); PG8_BAR; PG8_SCHED;
            } else {
            PG8_LDB(B0, 0, 0); PG8_SCHED; PG8_LDA(At, 0, 0); PG8_STAGE(PG8_SA(1, 1), a1 + hstep, voffA);
            PG8_WAIT_L(8); PG8_BAR; PG8_WAIT_L(0); PG8_MMA(0, 0, At, B0); PG8_BAR; PG8_SCHED;
            PG8_LDB(B1, 0, 1); PG8_STAGE(PG8_SB(0, 0), b2, voffB);
            PG8_BAR; PG8_WAIT_L(0); PG8_MMA(0, 1, At, B1); PG8_BAR;
            PG8_LDA(At, 0, 1); PG8_STAGE(PG8_SA(0, 0), a2, voffA);
            PG8_BAR; PG8_WAIT_L(0); PG8_MMA(1, 0, At, B0); PG8_BAR; PG8_SCHED;
            PG8_STAGE(PG8_SB(0, 1), b2 + hstep, voffB);
            PG8_WAIT_V(6); PG8_BAR; PG8_MMA(1, 1, At, B1); PG8_BAR;
            PG8_LDB(B0, 1, 0); PG8_SCHED; PG8_LDA(At, 1, 0); PG8_STAGE(PG8_SA(0, 1), a2 + hstep, voffA);
            PG8_WAIT_L(8); PG8_BAR; PG8_WAIT_L(0); PG8_MMA(0, 0, At, B0); PG8_BAR; PG8_SCHED;
            PG8_LDB(B1, 1, 1); PG8_STAGE(PG8_SB(1, 0), b3, voffB);
            PG8_BAR; PG8_WAIT_L(0); PG8_MMA(0, 1, At, B1); PG8_BAR;
            PG8_LDA(At, 1, 1); PG8_STAGE(PG8_SA(1, 0), a3, voffA);
            PG8_BAR; PG8_WAIT_L(0); PG8_MMA(1, 0, At, B0); PG8_BAR; PG8_SCHED;
            PG8_STAGE(PG8_SB(1, 1), b3 + hstep, voffB);
            PG8_WAIT_V(6); PG8_BAR; PG8_MMA(1, 1, At, B1); PG8_BAR;
            }
        }
        if constexpr (ALIGN_EPI) { if (wr == 0) PG8_BAR; }
        if constexpr (!Epi::AFTER_DRAIN) { E(acc, cur, wr, wc, fr, fq); S.done(cur); }
        if (!has_next) break;
#pragma unroll
        for (int a = 0; a < 2; ++a)
#pragma unroll
            for (int b = 0; b < 2; ++b)
#pragma unroll
                for (int m = 0; m < 4; ++m)
#pragma unroll
                    for (int n = 0; n < 2; ++n) acc[a][b][m][n] = (f32x4){0.f, 0.f, 0.f, 0.f};
        cur = nxt; cA = nA; cB = nB; ++ui;
        if constexpr (ALIGN_EPI) { if (wr == 1) PG8_BAR; }
    }
    PG8_WAIT_V(0);
    if constexpr (!ALIGN_EPI) { if (wr == 0) PG8_BAR; }
    PG8_BAR;
    if constexpr (Epi::AFTER_DRAIN) { E.fused(acc, cur, wr, wc, fr, fq, lds, wid, lane); S.done(cur); }
#undef PG8_SA
#undef PG8_SB
#undef PG8_STAGE
#undef PG8_LDA
#undef PG8_LDB
#undef PG8_MMA
#undef PG8_WAIT_V
#undef PG8_WAIT_L
#undef PG8_BAR
#undef PG8_SCHED
}
}
namespace att {
constexpr int SEQ = 4096, NH = 8, QP = 1536, KNP = 128, KRP = 64, VP = 128, OP = 1024;
constexpr float SCALE = 0.07216878364870322f;
constexpr float THR = 8.f;
constexpr int NW = 8, QBLK = 32, KVBLK = 64, QB = NW * QBLK;
constexpr int KROW = 512;
constexpr int SHM_V = KVBLK * 128 * 2, SHM_K = KVBLK * KROW;
constexpr int LDS_BYTES = 3 * SHM_V + 2 * SHM_K + NW * 64 * 4;
constexpr int WIN = 1 << 30;
typedef short bf16x8 __attribute__((ext_vector_type(8)));
typedef short s16x4 __attribute__((ext_vector_type(4)));
typedef float f32x16 __attribute__((ext_vector_type(16)));
typedef float f32x4 __attribute__((ext_vector_type(4)));
typedef unsigned u32x4 __attribute__((ext_vector_type(4)));
typedef unsigned short bf16;
#define KSWZ(row, colB) ((row) * KROW + ((colB) ^ (((row) & 15) << 4)))
#define SBAR() __builtin_amdgcn_sched_barrier(0)
__device__ __forceinline__ int v_st(int k, int c) { const int kk = (k & ~0xC) | ((k & 4) << 1) | ((k & 8) >> 1); return ((kk >> 3) * 4 + (c >> 5)) * 512 + ((kk & 7) * 32 + (c & 31)) * 2; }
__device__ __forceinline__ int v_rd_base(int lane) { return ((lane & 3) << 3) | (((lane >> 2) & 3) << 6) | (((lane >> 4) & 1) << 5) | (((lane >> 5) & 1) << 8); }
constexpr int v_rd_off(int d0, int ks, int half) { return d0 * 512 + ks * 4096 + half * 2048; }
__device__ __forceinline__ int crow(int r, int hi) { return (r & 3) + 8 * (r >> 2) + 4 * hi; }
typedef float f32x2_cv __attribute__((ext_vector_type(2))); typedef __bf16 bf16x2_cv __attribute__((ext_vector_type(2)));
__device__ __forceinline__ unsigned cvtpk(float lo, float hi) { f32x2_cv v = {lo, hi}; bf16x2_cv b = __builtin_convertvector(v, bf16x2_cv); return __builtin_bit_cast(unsigned, b); }
__device__ __forceinline__ bf16x8 load8(const bf16* p) { return *reinterpret_cast<const bf16x8*>(p); }
__device__ __forceinline__ void mask_tile(f32x16& p0, f32x16& p1, int dq, unsigned W) {
    const float NEG = -__builtin_inff();
#pragma unroll
    for (int r = 0; r < 16; ++r) {
        const int c = (r & 3) + 8 * (r >> 2);
        if ((unsigned)(dq - c) >= W) p0[r] = NEG;
        if ((unsigned)(dq - c - 32) >= W) p1[r] = NEG;
    }
}
__device__ __forceinline__ void partialSM(f32x16& p0, f32x16& p1, float& m_reg, float& mn, float& alpha) {
    float pmax = p0[0]; for (int r = 1; r < 16; ++r) pmax = fmaxf(pmax, p0[r]); for (int r = 0; r < 16; ++r) pmax = fmaxf(pmax, p1[r]);
    { auto rr = __builtin_amdgcn_permlane32_swap(__float_as_uint(pmax), __float_as_uint(pmax), false, false);
      pmax = fmaxf(__uint_as_float(rr[0]), __uint_as_float(rr[1])); }
    constexpr float C2 = 1.4426950408889634f * SCALE;
    if (__builtin_expect(__all((pmax - m_reg) * SCALE <= THR), 1)) { mn = m_reg; alpha = 1.f; }
    else { mn = fmaxf(m_reg, pmax); alpha = __builtin_amdgcn_exp2f((m_reg - mn) * C2); m_reg = mn; }
    const float mnL = -mn * C2;
    for (int r = 0; r < 16; ++r) p0[r] = fmaf(p0[r], C2, mnL); for (int r = 0; r < 16; ++r) p1[r] = fmaf(p1[r], C2, mnL);
    for (int r = 0; r < 16; ++r) p0[r] = __builtin_amdgcn_exp2f(p0[r]);
}
__device__ __forceinline__ void finishSM(f32x16& p0, f32x16& p1, float alpha, float& l_reg, bf16x8& pa0, bf16x8& pa1, bf16x8& pa2, bf16x8& pa3) {
    for (int r = 0; r < 16; ++r) p1[r] = __builtin_amdgcn_exp2f(p1[r]);
    float ps = 0; for (int r = 0; r < 16; ++r) ps += p0[r]; for (int r = 0; r < 16; ++r) ps += p1[r];
    { auto rr = __builtin_amdgcn_permlane32_swap(__float_as_uint(ps), __float_as_uint(ps), false, false);
      ps = __uint_as_float(rr[0]) + __uint_as_float(rr[1]); }
    l_reg = l_reg * alpha + ps;
#define PK4(P, B_, OUT) do { unsigned a0 = cvtpk(P[B_+0], P[B_+1]), a1 = cvtpk(P[B_+2], P[B_+3]);                          \
        unsigned b0 = cvtpk(P[B_+4], P[B_+5]), b1 = cvtpk(P[B_+6], P[B_+7]);                                             \
        auto r0 = __builtin_amdgcn_permlane32_swap(a0, b0, false, false); auto r1 = __builtin_amdgcn_permlane32_swap(a1, b1, false, false); \
        u32x4 w = {r0[0], r1[0], r0[1], r1[1]}; OUT = *reinterpret_cast<bf16x8*>(&w); } while (0)
    PK4(p0, 0, pa0); PK4(p0, 8, pa1); PK4(p1, 0, pa2); PK4(p1, 8, pa3);
#undef PK4
}
template <int KB>
__device__ __forceinline__ void qkt(f32x16& p0, f32x16& p1, const char* K_lds, int r32, int hi, const bf16x8* qr) {
    p0 = f32x16{}; p1 = f32x16{};
    int kb[8];
#pragma unroll
    for (int dd = 0; dd < 8; ++dd) kb[dd] = (int)(uintptr_t)K_lds + KSWZ(r32, (dd * 16 + hi * 8) * 2);
    bf16x8 f0[4], f1[4];
#define KRD(d) do { asm volatile("ds_read_b128 %0, %1 offset:%2" : "=&v"(f0[(d) & 3]) : "v"(kb[(d) & 7]), "i"(KB * SHM_K + ((d) >> 3) * 256) : "memory");              \
                    asm volatile("ds_read_b128 %0, %1 offset:%2" : "=&v"(f1[(d) & 3]) : "v"(kb[(d) & 7]), "i"(KB * SHM_K + ((d) >> 3) * 256 + 32 * KROW) : "memory"); } while (0)
#define KMM(d, n) do { asm volatile("s_waitcnt lgkmcnt(" #n ")" ::: "memory"); SBAR();                                                                                 \
                       p0 = __builtin_amdgcn_mfma_f32_32x32x16_bf16(f0[(d) & 3], qr[d], p0, 0, 0, 0); p1 = __builtin_amdgcn_mfma_f32_32x32x16_bf16(f1[(d) & 3], qr[d], p1, 0, 0, 0); SBAR(); } while (0)
    KRD(0); KRD(1); KRD(2);
    __builtin_amdgcn_s_setprio(1);
    KRD(3); KMM(0, 6); KRD(4); KMM(1, 6); KRD(5); KMM(2, 6); KRD(6); KMM(3, 6); KRD(7); KMM(4, 6); KRD(8); KMM(5, 6);
    KRD(9); KMM(6, 6); KRD(10); KMM(7, 6); KRD(11); KMM(8, 6); KMM(9, 4); KMM(10, 2); KMM(11, 0);
    __builtin_amdgcn_s_setprio(0);
#undef KRD
#undef KMM
}
template <int VB>
__device__ __forceinline__ void pv_tile(f32x16* o, int vb0, bf16x8 pa0, bf16x8 pa1, bf16x8 pa2, bf16x8 pa3) {
#define TRRD(dst, off) asm volatile("ds_read_b64_tr_b16 %0, %1 offset:%2" : "=&v"(dst) : "v"(vb0), "i"(off) : "memory")
#define PV_RD(S_, d0) do { constexpr int b_ = VB * SHM_V + v_rd_off(d0, 0, 0); \
        TRRD(S_##l0, b_); TRRD(S_##h0, b_ + 2048); TRRD(S_##l1, b_ + 4096); TRRD(S_##h1, b_ + 6144); TRRD(S_##l2, b_ + 8192); TRRD(S_##h2, b_ + 10240); TRRD(S_##l3, b_ + 12288); TRRD(S_##h3, b_ + 14336); } while (0)
#define PV_MM(S_, d0) do { \
        o[d0] = __builtin_amdgcn_mfma_f32_32x32x16_bf16(pa0, (bf16x8){S_##l0[0], S_##l0[1], S_##l0[2], S_##l0[3], S_##h0[0], S_##h0[1], S_##h0[2], S_##h0[3]}, o[d0], 0, 0, 0);   \
        o[d0] = __builtin_amdgcn_mfma_f32_32x32x16_bf16(pa1, (bf16x8){S_##l1[0], S_##l1[1], S_##l1[2], S_##l1[3], S_##h1[0], S_##h1[1], S_##h1[2], S_##h1[3]}, o[d0], 0, 0, 0);   \
        o[d0] = __builtin_amdgcn_mfma_f32_32x32x16_bf16(pa2, (bf16x8){S_##l2[0], S_##l2[1], S_##l2[2], S_##l2[3], S_##h2[0], S_##h2[1], S_##h2[2], S_##h2[3]}, o[d0], 0, 0, 0);   \
        o[d0] = __builtin_amdgcn_mfma_f32_32x32x16_bf16(pa3, (bf16x8){S_##l3[0], S_##l3[1], S_##l3[2], S_##l3[3], S_##h3[0], S_##h3[1], S_##h3[2], S_##h3[3]}, o[d0], 0, 0, 0); } while (0)
#define LW(n) asm volatile("s_waitcnt lgkmcnt(" #n ")" ::: "memory")
    s16x4 Al0, Al1, Al2, Al3, Ah0, Ah1, Ah2, Ah3, Bl0, Bl1, Bl2, Bl3, Bh0, Bh1, Bh2, Bh3;
    PV_RD(A, 0); PV_RD(B, 1); LW(8); SBAR(); __builtin_amdgcn_s_setprio(1);
    PV_MM(A, 0); SBAR(); PV_RD(A, 2); LW(8); SBAR();
    PV_MM(B, 1); SBAR(); PV_RD(B, 3); LW(8); SBAR();
    PV_MM(A, 2); SBAR(); LW(0); SBAR();
    PV_MM(B, 3); __builtin_amdgcn_s_setprio(0);
#undef LW
#undef PV_MM
#undef PV_RD
#undef TRRD
}
struct BlockRef { const bf16* Q; const bf16* KN; const bf16* KR; const bf16* V; bf16* O; int P0; };
struct Seam { bf16x8 qr[12]; bf16x8 st_k0, st_k1, st_k2; };
#define VMW() asm volatile("s_waitcnt vmcnt(0)" ::: "memory")
#define VMWN(n) asm volatile("s_waitcnt vmcnt(%0)" :: "i"(n) : "memory")
#define SLOAD_H(R, k0) do { S.st_k0 = load8((R).KN + (size_t)((k0) + sr) * KNP + sc); S.st_k1 = load8((R).KN + (size_t)((k0) + 32 + sr) * KNP + sc);     \
                            S.st_k2 = load8((R).KR + (size_t)((k0) + kr) * KRP + rc); } while (0)
#define SWRITE_HK(bf) do { *(bf16x8*)(K_lds + (bf) * SHM_K + kws) = S.st_k0; *(bf16x8*)(K_lds + (bf) * SHM_K + kws + 32 * KROW) = S.st_k1; *(bf16x8*)(K_lds + (bf) * SHM_K + kws2) = S.st_k2; } while (0)
#define SWRITE_HV(bf) do { *(bf16x8*)(V_lds + (bf) * SHM_V + vst0) = S.st_k0; *(bf16x8*)(V_lds + (bf) * SHM_V + vst1) = S.st_k1; } while (0)
#define SWRITE_H(bf) do { SWRITE_HV(bf); SWRITE_HK(bf); } while (0)
__device__ __forceinline__ BlockRef make_ref(int L, int pass, const bf16* Q, const bf16* KN, const bf16* KR, const bf16* V, bf16* O) {
    const int bh = L >> 3, x = L & 7, qb = pass ? 15 - x : x, b = bh / NH, h = bh % NH;
    const size_t r0 = (size_t)b * SEQ;
    BlockRef r; r.Q = Q + (r0 + (size_t)qb * QB) * QP + h * 192; r.O = O + (r0 + (size_t)qb * QB) * OP + h * 128;
    r.KN = KN + r0 * KNP; r.KR = KR + r0 * KRP; r.V = V + r0 * VP; r.P0 = qb * QB;
    return r;
}
__device__ __forceinline__ void attn_phase(char* lds, const bf16* Q, const bf16* KN, const bf16* KR, const bf16* V, bf16* O, int first, int stride, int total) {
    if (first >= total) return;
    const int tid = threadIdx.x, wid = __builtin_amdgcn_readfirstlane(tid >> 6), lane = tid & 63, r32 = lane & 31, hi = lane >> 5; const bool grpB = wid >= 4;
    char* V_lds = lds; char* K_lds = lds + 3 * SHM_V;
    float* ws = (float*)(lds + 3 * SHM_V + 2 * SHM_K) + wid * 64; float* li_l = ws, * al_l = ws + 32;
    const int sr = tid >> 4, sc = (tid & 15) * 8, vst0 = v_st(sr, sc), vst1 = v_st(32 + sr, sc), kws = KSWZ(sr, sc * 2), kr = tid >> 3, rc = (tid & 7) * 8, kws2 = KSWZ(kr, (128 + rc) * 2);
    const int vb0 = (int)(uintptr_t)V_lds + v_rd_base(lane);
    Seam S;
    int cL = first, cpass = 0;
    BlockRef cur = make_ref(cL, 0, Q, KN, KR, V, O), nxt = cur; bool has_nxt;
#define ADVANCE() do { if (cpass == 0) { cpass = 1; has_nxt = true; } else if (cL + stride < total) { cL += stride; cpass = 0; has_nxt = true; } else has_nxt = false; \
                       if (has_nxt) nxt = make_ref(cL, cpass, Q, KN, KR, V, O); } while (0)
    ADVANCE();
    float m_reg = -1e30f, l_reg = 0; f32x16 o[4] = {};
    f32x16 p0, p1; float mn, al; bf16x8 pa0, pa1, pa2, pa3;
    int vs = 0; bool sv = false, qpend = false, more = true;
#pragma unroll
    for (int d0 = 0; d0 < 12; ++d0) S.qr[d0] = load8(cur.Q + (size_t)(wid * QBLK + r32) * QP + d0 * 16 + hi * 8);
    SLOAD_H(cur, 0); VMW(); SWRITE_HV(0); SWRITE_HK(0);
    __syncthreads();
    SLOAD_H(cur, KVBLK); sv = true;
#define RESC(a) do { if (__any((a) < 1.f)) { if (hi == 0) al_l[r32] = (a); asm volatile("s_waitcnt lgkmcnt(0)" ::: "memory");              \
                     for (int d_ = 0; d_ < 4; ++d_) for (int r = 0; r < 16; ++r) o[d_][r] *= al_l[crow(r, hi)]; } } while (0)
#define MASKT(P0_, P1_, t) do { const int kb_ = (t) * KVBLK; if (kb_ + KVBLK - 1 > qlo) mask_tile(P0_, P1_, qm - kb_, (unsigned)WIN); } while (0)
#define EPILOGUE(Optr) do { if (hi == 0) li_l[r32] = l_reg; asm volatile("s_waitcnt lgkmcnt(0)" ::: "memory");                              \
        { float rli[16]; _Pragma("unroll") for (int r = 0; r < 16; ++r) rli[r] = __builtin_amdgcn_rcpf(li_l[crow(r, hi)]);                   \
          bf16* Ow = (Optr) + (size_t)(wid * QBLK) * OP;                                                                                     \
          _Pragma("unroll") for (int r = 0; r < 16; ++r) { const int orow = crow(r, hi);                                                     \
            _Pragma("unroll") for (int d0 = 0; d0 < 4; ++d0) { const float v = o[d0][r] * rli[r]; const float vn = __shfl_xor(v, 1);         \
                if ((r32 & 1) == 0) *(unsigned*)(Ow + (size_t)orow * OP + d0 * 32 + r32) = cvtpk(v, vn); } } }                               \
        m_reg = -1e30f; l_reg = 0; o[0] = f32x16{}; o[1] = f32x16{}; o[2] = f32x16{}; o[3] = f32x16{}; } while (0)
#define END_STEP(t, KB) do { const int vsn_ = (vs == 2) ? 0 : vs + 1;                                                                   \
        if (sv) { if (qpend) { VMWN(12); } else { VMW(); } SWRITE_HV(vsn_); SWRITE_HK((KB) ^ 1); sv = false; } qpend = false;             \
        __syncthreads();                                                                                                                 \
        if ((t) + 2 < NT) { SLOAD_H(cur, ((t) + 2) * KVBLK); sv = true; } else if (has_nxt) { SLOAD_H(nxt, ((t) + 2 - NT) * KVBLK); sv = true; } SBAR(); } while (0)
#define TILE(t, KB, LASTQ) do {                                                                                                         \
        qkt<KB>(p0, p1, K_lds, r32, hi, S.qr); SBAR();                                                                                   \
        if (LASTQ) { if ((t) + 1 >= NT && has_nxt) { _Pragma("unroll") for (int d0 = 0; d0 < 12; ++d0) S.qr[d0] = load8(nxt.Q + (size_t)(wid * QBLK + r32) * QP + d0 * 16 + hi * 8); qpend = true; } SBAR(); } \
        MASKT(p0, p1, (t)); partialSM(p0, p1, m_reg, mn, al); finishSM(p0, p1, al, l_reg, pa0, pa1, pa2, pa3); RESC(al); SBAR();         \
        if (grpB) END_STEP(t, KB);                                                                                                       \
        pv_tile<0>(o, vb0 + vs * SHM_V, pa0, pa1, pa2, pa3); SBAR();                                                                     \
        if (!grpB) END_STEP(t, KB);                                                                                                      \
        vs = (vs == 2) ? 0 : vs + 1; } while (0)
    while (more) {
        const int NT = (cur.P0 + QB - 1) / KVBLK + 1, qlo = cur.P0 + wid * QBLK, qm = qlo + r32 - 4 * hi;
        for (int t = 0; t < NT; t += 2) { TILE(t, 0, false); TILE(t + 1, 1, true); }
        EPILOGUE(cur.O);
        more = has_nxt; if (more) { cur = nxt; ADVANCE(); }
    }
    __syncthreads();
#undef END_STEP
#undef TILE
#undef ADVANCE
#undef RESC
#undef MASKT
#undef EPILOGUE
}
#undef VMW
#undef VMWN
#undef SLOAD_H
#undef SWRITE_HK
#undef SWRITE_HV
#undef SWRITE_H
#undef KSWZ
#undef SBAR
}
#ifndef MK_LAUNCHES
#define MK_LAUNCHES 1
#endif
constexpr int NWAVES = 8;
constexpr int BATCH = 16, SEQ = 4096, DM = 1024, M = BATCH * SEQ, FF = 4096, NZ = 3072, IN_COLS = 3008;
constexpr float EPS = 1e-6f;
constexpr size_t MiB = 1u << 20;
constexpr size_t WS_SSQ = 1 * MiB;
constexpr size_t WS_WIN = 2 * MiB, WS_WUQ = 8 * MiB, WS_WUKV = 9 * MiB, WS_WCOMB = 10 * MiB, WS_WATT = 11 * MiB, WS_WOUT = 13 * MiB, WS_W1 = 15 * MiB, WS_W2 = 23 * MiB;
constexpr size_t WS_XN = 32 * MiB;
constexpr size_t WS_U = 160 * MiB, WS_CQ = 224 * MiB, WS_CKV = 256 * MiB;
constexpr size_t WS_O = 160 * MiB;
constexpr size_t WS_GA = 288 * MiB, WS_GB = 416 * MiB, WS_POOLED = 544 * MiB, WS_Q = 608 * MiB, WS_KN = 800 * MiB;
constexpr size_t WS_KR = 928 * MiB, WS_COS = 936 * MiB, WS_SIN = 944 * MiB, WS_END = 952 * MiB;
constexpr size_t WS_H = 416 * MiB;
constexpr int RING_BYTES = 131072, LDS_BYTES = 147456;

#define GAS __attribute__((address_space(1)))
#define LAS __attribute__((address_space(3)))
typedef unsigned short bf16;
typedef unsigned v4u __attribute__((ext_vector_type(4)));
typedef float f32x4 __attribute__((ext_vector_type(4)));
#define LDS_WAIT() asm volatile("s_waitcnt lgkmcnt(0)" ::: "memory")
__device__ __forceinline__ unsigned f2bf(float f) { unsigned u = __builtin_bit_cast(unsigned, f); return (u + 0x7fffu + ((u >> 16) & 1u)) >> 16; }
__device__ __forceinline__ unsigned pk2(float lo, float hi) { return f2bf(lo) | (f2bf(hi) << 16); }
__device__ __forceinline__ float bflo(unsigned w) { return __uint_as_float(w << 16); }
__device__ __forceinline__ float bfhi(unsigned w) { return __uint_as_float(w & 0xffff0000u); }
__device__ __forceinline__ float wave_sum(float v) {
#pragma unroll
    for (int o = 1; o < 64; o <<= 1) v += __shfl_xor(v, o);
    return v;
}
struct Args {
    const float* x; const int* pos; const float *g_mix, *w_in, *b_gate, *pool_w, *pool_scale, *w_pool_proj, *g_q, *w_uq, *g_kv, *w_ukv, *w_attn, *w_out, *g_mlp, *w1, *w2, *g_final;
    float* out; unsigned char* ws; int ph_lo, ph_hi;
};
struct MapId { static __device__ __forceinline__ int src(int j) { return j; } };
struct MapWin { static __device__ __forceinline__ int src(int j) { if (j < 896) return j; if (j < 960) { const int jj = j - 896; return 896 + (jj & 1) * 32 + (jj >> 1); } if (j < 1024) return -1; return j - 64; } };
struct MapWuq { static __device__ __forceinline__ int src(int j) { if (j < 1024) return (j >> 7) * 192 + (j & 127); const int jj = j - 1024, h = jj >> 6, r = jj & 63; return h * 192 + 128 + (r & 1) * 32 + (r >> 1); } };
template <class MAP> __device__ __forceinline__ void transpose_item(const float* W, int K, int Nsrc, int nblk, bf16* WT, const float* rs, LAS float* scr, int item, int lane, int nb0 = 0) {
    const int kb = item / nblk, nb = nb0 + item % nblk, k0 = 64 * kb, n0 = 32 * nb;
    const int s = MAP::src(n0 + (lane & 31));
#pragma unroll 8
    for (int i = 0; i < 32; ++i) { const int kk = 2 * i + (lane >> 5); float v = 0.f; if (s >= 0) { v = W[(size_t)(k0 + kk) * Nsrc + s]; if (rs) v *= rs[k0 + kk]; } scr[kk * 33 + (lane & 31)] = v; }
    LDS_WAIT(); asm volatile("" ::: "memory");
    const int c = lane & 7;
#pragma unroll
    for (int j = 0; j < 4; ++j) { const int n = (lane >> 3) + 8 * j; const LAS float* sp = scr + (8 * c) * 33 + n;
        v4u o; o.x = pk2(sp[0 * 33], sp[1 * 33]); o.y = pk2(sp[2 * 33], sp[3 * 33]); o.z = pk2(sp[4 * 33], sp[5 * 33]); o.w = pk2(sp[6 * 33], sp[7 * 33]);
        *(GAS v4u*)(WT + (size_t)(n0 + n) * K + k0 + 8 * c) = o; }
    LDS_WAIT(); asm volatile("" ::: "memory");
}

#define XB_TMO      128
#define XB_XCNT(j)  (256  + 64 * (j))
#define XB_XSUB(j)  (1280 + 64 * (j))
#define XB_XGEN(j)  (2304 + 64 * (j))
#define XB_TOP      3328
#define XB_TOPGEN   3392
#define XCD_BAR_WORDS 3456
#define XB_SPIN_CAP (1u << 18)

__device__ __forceinline__ unsigned xb_ld(unsigned* p)              { return __hip_atomic_load(p, __ATOMIC_RELAXED, __HIP_MEMORY_SCOPE_AGENT); }
__device__ __forceinline__ unsigned xb_add(unsigned* p, unsigned v) { return __hip_atomic_fetch_add(p, v, __ATOMIC_RELAXED, __HIP_MEMORY_SCOPE_AGENT); }
__device__ __forceinline__ unsigned xb_xcc_id() { return (unsigned)__builtin_amdgcn_s_getreg((3 << 11) | 20) & 0xFu; }
#define XB_SPIN(cond, bar) do { unsigned _sp = 0; while (cond) { __builtin_amdgcn_s_sleep(1); \
    if ((++_sp & 255u) == 0u) { if (xb_ld(&(bar)[XB_TMO])) break; if (_sp > XB_SPIN_CAP) { atomicAdd(&(bar)[XB_TMO], 1u); break; } } } } while (0)

struct XcdBarrier {
    unsigned* bar; unsigned x;
    volatile LAS unsigned* st;
};

__device__ __forceinline__ XcdBarrier xcd_barrier_post(unsigned* bar, volatile LAS unsigned* st) {
    XcdBarrier b; b.bar = bar; b.x = xb_xcc_id(); b.st = st;
    if (threadIdx.x == 0) (void)xb_add(&bar[XB_XCNT(b.x)], 1u);
    return b;
}
__device__ __forceinline__ void xcd_barrier_complete(unsigned* bar, unsigned x, unsigned& nloc, unsigned& nx) {
    const unsigned G = gridDim.x * gridDim.y * gridDim.z;
    unsigned sum, cnt, mine, sp = 0u;
    for (;;) {
        sum = 0u; cnt = 0u; mine = 0u;
#pragma unroll
        for (unsigned j = 0; j < 16; ++j) { const unsigned c = xb_ld(&bar[XB_XCNT(j)]); sum += c; cnt += (c > 0u) ? 1u : 0u; mine = (j == x) ? c : mine; }
        if (sum == G) break;
        __builtin_amdgcn_s_sleep(1);
        if ((++sp & 255u) == 0u) { if (xb_ld(&bar[XB_TMO])) break; if (sp > XB_SPIN_CAP) { atomicAdd(&bar[XB_TMO], 1u); break; } }
    }
    nloc = mine > 0u ? mine : 1u; nx = cnt > 0u ? cnt : 1u;
}

__device__ __forceinline__ void xcd_barrier(const XcdBarrier& b) {
    asm volatile("s_waitcnt vmcnt(0)" ::: "memory");
    __syncthreads();
    if (threadIdx.x == 0) {
        unsigned* bar = b.bar;
        __builtin_amdgcn_s_waitcnt(0);
        unsigned nloc = b.st[0], nx = b.st[1];
        if (nloc == 0u) { xcd_barrier_complete(bar, b.x, nloc, nx); b.st[0] = nloc; b.st[1] = nx; }
        const unsigned old = xb_add(&bar[XB_XSUB(b.x)], 1u);
        const unsigned gen = old / nloc;
        if (old + 1u == (gen + 1u) * nloc) {
            __builtin_amdgcn_fence(__ATOMIC_RELEASE, "agent");
            asm volatile("s_waitcnt vmcnt(0)" ::: "memory");
            const unsigned og = xb_add(&bar[XB_TOP], 1u);
            const unsigned tg = og / nx;
            if (og + 1u == (tg + 1u) * nx) xb_add(&bar[XB_TOPGEN], 1u);
            else XB_SPIN(xb_ld(&bar[XB_TOPGEN]) == tg, bar);
            __builtin_amdgcn_fence(__ATOMIC_ACQUIRE, "agent");
            xb_add(&bar[XB_XGEN(b.x)], 1u);
            asm volatile("s_waitcnt vmcnt(0)" ::: "memory");
        } else {
            XB_SPIN(xb_ld(&bar[XB_XGEN(b.x)]) == gen, bar);
            __builtin_amdgcn_fence(__ATOMIC_ACQUIRE, "agent");
            asm volatile("s_waitcnt vmcnt(0)" ::: "memory");
        }
    }
    __syncthreads();
}

__global__ void __launch_bounds__(NWAVES * 64, 2) mk_fwd(Args a) {
    extern __shared__ __attribute__((aligned(16))) unsigned char lds[];
    cg::grid_group grid = cg::this_grid();
    const int tid = threadIdx.x, lane = tid & 63, wave = __builtin_amdgcn_readfirstlane(tid >> 6);
    const int G = gridDim.x, bx = blockIdx.x, vcu = (G % 8 == 0) ? (bx % 8) * (G / 8) + bx / 8 : bx;
    const int gw = vcu * NWAVES + wave, NGW = G * NWAVES;
    unsigned char* ws = a.ws;
    float* ssq_q = (float*)(ws + WS_SSQ); float* ssq_kv = ssq_q + M; float* ssq1 = ssq_kv + M; float* ssq2 = ssq1 + M;
    bf16 *Win_t = (bf16*)(ws + WS_WIN), *Wuq_t = (bf16*)(ws + WS_WUQ), *Wcomb_t = (bf16*)(ws + WS_WCOMB), *Watt_t = (bf16*)(ws + WS_WATT), *Wout_t = (bf16*)(ws + WS_WOUT), *W1_t = (bf16*)(ws + WS_W1), *W2_t = (bf16*)(ws + WS_W2);
    bf16 *XN = (bf16*)(ws + WS_XN), *X1B = (bf16*)(ws + WS_XN), *X2B = (bf16*)(ws + WS_O);
    bf16 *U = (bf16*)(ws + WS_U), *CQ = (bf16*)(ws + WS_CQ), *CKV = (bf16*)(ws + WS_CKV), *Ob = (bf16*)(ws + WS_O);
    bf16 *GA = (bf16*)(ws + WS_GA); unsigned char *GA8 = ws + WS_GB, *GB8 = ws + WS_GB + 64 * MiB;
    bf16 *POOLED = (bf16*)(ws + WS_POOLED), *Qb = (bf16*)(ws + WS_Q), *LAT = (bf16*)(ws + WS_KN), *KR = (bf16*)(ws + WS_KR), *Hb = (bf16*)(ws + WS_H);
    float *cosT = (float*)(ws + WS_COS), *sinT = (float*)(ws + WS_SIN), *rms0 = (float*)(ws + 31 * MiB);
    PG8_LAS unsigned char* ring = (PG8_LAS unsigned char*)lds;
    const int lo = a.ph_lo, hi = a.ph_hi;
    volatile LAS unsigned* xst = (volatile LAS unsigned*)((LAS unsigned char*)lds + RING_BYTES);
    if (tid < 2) xst[tid] = 0u;
    __syncthreads();
    XcdBarrier bar; bar.bar = (unsigned*)ws; bar.x = 0; bar.st = xst;
    if (hi - lo > 1) bar = xcd_barrier_post((unsigned*)ws, xst);
    if (lo > 1000) grid.sync();
#ifdef ONLYP
#define IN(k) ((k) == ONLYP && lo <= (k) && (k) < hi)
#else
#define IN(k) (lo <= (k) && (k) < hi)
#endif
#define SEAM(k) do { if (IN(k) && IN((k) + 1)) xcd_barrier(bar); } while (0)

    if (IN(0)) {
        LAS float* scr = (LAS float*)((LAS unsigned char*)lds + wave * 16384);
        constexpr int I_IN = 16 * 96, I_UQ = 4 * 16, I_QABS = 512, I_ATT = 2048, I_OUT = 16 * 32, I_1 = 16 * 128, I_2 = 64 * 32, I_COMB = 1024;
        constexpr int NITEMS = I_IN + I_UQ + I_QABS + I_ATT + I_OUT + I_1 + I_2 + I_COMB;
        const int hw = gw >> 1, NHW = NGW >> 1;
        if (wave & 1) {
        for (int it = hw; it < NITEMS; it += NHW) {
            int r = it;
            if (r < I_IN) { transpose_item<MapWin>(a.w_in, 1024, IN_COLS, 96, Win_t, nullptr, scr, r, lane); continue; } r -= I_IN;
            if (r < I_UQ) { transpose_item<MapWuq>(a.w_uq, 256, 1536, 16, Wuq_t, a.g_q, scr, r, lane, 32); continue; } r -= I_UQ;
            if (r < I_QABS) {
                for (int e = r * 64 + lane; e < 1024 * 32; e += I_QABS * 64) { const int row = e >> 5, k8 = e & 31, h = row >> 7, j = row & 127;
                    float acc8[8] = {0.f, 0.f, 0.f, 0.f, 0.f, 0.f, 0.f, 0.f};
                    const float* kvp = a.w_ukv + (size_t)j * 2048 + h * 256; const float* uqp = a.w_uq + (size_t)(k8 * 8) * 1536 + h * 192;
                    for (int d4 = 0; d4 < 32; ++d4) { const f32x4 kv = *(const f32x4*)(kvp + 4 * d4);
#pragma unroll
                        for (int i = 0; i < 8; ++i) { const f32x4 uq = *(const f32x4*)(uqp + (size_t)i * 1536 + 4 * d4); acc8[i] += (kv.x * uq.x + kv.y * uq.y) + (kv.z * uq.z + kv.w * uq.w); } }
                    const float gj = a.g_kv[j]; const float* gq = a.g_q + k8 * 8;
                    v4u o; o.x = pk2(acc8[0] * gj * gq[0], acc8[1] * gj * gq[1]); o.y = pk2(acc8[2] * gj * gq[2], acc8[3] * gj * gq[3]); o.z = pk2(acc8[4] * gj * gq[4], acc8[5] * gj * gq[5]); o.w = pk2(acc8[6] * gj * gq[6], acc8[7] * gj * gq[7]);
                    *(GAS v4u*)(Wuq_t + (size_t)row * 256 + k8 * 8) = o; }
                continue; } r -= I_QABS;
            if (r < I_ATT) {
                const int nblk = r & 15, kk8 = r >> 4, h = kk8 >> 4, j0 = (kk8 & 15) * 8, n = nblk * 64 + lane;
                float acc8[8] = {0.f, 0.f, 0.f, 0.f, 0.f, 0.f, 0.f, 0.f};
                const float* kvp = a.w_ukv + (size_t)j0 * 2048 + h * 256 + 128;
                for (int d = 0; d < 128; ++d) { const float w = a.w_attn[(size_t)(h * 128 + d) * 1024 + n];
#pragma unroll
                    for (int i = 0; i < 8; ++i) acc8[i] += kvp[(size_t)i * 2048 + d] * w; }
                const float* gk = a.g_kv + j0;
                v4u o; o.x = pk2(acc8[0] * gk[0], acc8[1] * gk[1]); o.y = pk2(acc8[2] * gk[2], acc8[3] * gk[3]); o.z = pk2(acc8[4] * gk[4], acc8[5] * gk[5]); o.w = pk2(acc8[6] * gk[6], acc8[7] * gk[7]);
                *(GAS v4u*)(Watt_t + (size_t)n * 1024 + h * 128 + j0) = o;
                continue; } r -= I_ATT;
            if (r < I_OUT) { transpose_item<MapId>(a.w_out, 1024, 1024, 32, Wout_t, nullptr, scr, r, lane); continue; } r -= I_OUT;
            if (r < I_1) { transpose_item<MapId>(a.w1, 1024, 4096, 128, W1_t, a.g_mlp, scr, r, lane); continue; } r -= I_1;
            if (r < I_2) { transpose_item<MapId>(a.w2, 4096, 1024, 32, W2_t, nullptr, scr, r, lane); continue; } r -= I_2;
            {
                const int g = r >> 8, c8 = (r >> 4) & 15, d = (r & 15) * 64 + lane;
                float acc8[8] = {0.f, 0.f, 0.f, 0.f, 0.f, 0.f, 0.f, 0.f};
                const float* pw = a.pool_w + (size_t)(g * 128 + c8 * 8) * 128;
                for (int e = 0; e < 128; ++e) { const float w = a.w_pool_proj[(size_t)(g * 128 + e) * 1024 + d] * a.pool_scale[g * 128 + e];
#pragma unroll
                    for (int cc = 0; cc < 8; ++cc) acc8[cc] += pw[cc * 128 + e] * w; }
                v4u o; o.x = pk2(acc8[0], acc8[1]); o.y = pk2(acc8[2], acc8[3]); o.z = pk2(acc8[4], acc8[5]); o.w = pk2(acc8[6], acc8[7]);
                *(GAS v4u*)(Wcomb_t + (size_t)d * 512 + g * 128 + c8 * 8) = o;
            }
        }
        for (int e = ((hw * 64) + lane); e < M * 32; e += NHW * 64) {
            const int row = e >> 5, i = e & 31;
            const float inv = (float)exp2((double)(-i) * (13.287712379549449 / 32.0));
            const float ang = (float)a.pos[row] * inv;
            double rev = (double)ang * 0.15915494309189535; rev -= rint(rev);
            const float rr = (float)(rev * 6.283185307179586);
            cosT[e] = cosf(rr); sinT[e] = sinf(rr);
        }
        } else {
        for (int m = 2 * hw; m < M; m += 2 * NHW) {
            const GAS f32x4* xr = (const GAS f32x4*)(a.x + (size_t)m * DM) + lane; const GAS f32x4* gr = (const GAS f32x4*)a.g_mix + lane;
            f32x4 v[2][4]; float s2[2] = {0.f, 0.f};
#pragma unroll
            for (int r = 0; r < 2; ++r)
#pragma unroll
                for (int j = 0; j < 4; ++j) v[r][j] = xr[r * 256 + 64 * j];
#pragma unroll
            for (int r = 0; r < 2; ++r)
#pragma unroll
                for (int j = 0; j < 4; ++j) s2[r] += (v[r][j].x * v[r][j].x + v[r][j].y * v[r][j].y) + (v[r][j].z * v[r][j].z + v[r][j].w * v[r][j].w);
#pragma unroll
            for (int r = 0; r < 2; ++r) { const float rms = sqrtf(wave_sum(s2[r]) * (1.f / DM) + EPS), rstd = 1.0f / rms; if (lane == 0) rms0[m + r] = rms;
                GAS unsigned long long* o8 = (GAS unsigned long long*)(XN + (size_t)(m + r) * DM) + lane;
#pragma unroll
                for (int j = 0; j < 4; ++j) { const f32x4 g = gr[64 * j]; o8[64 * j] = (unsigned long long)pk2(v[r][j].x * rstd * g.x, v[r][j].y * rstd * g.y) | ((unsigned long long)pk2(v[r][j].z * rstd * g.z, v[r][j].w * rstd * g.w) << 32); } }
        }
        }
    }
    SEAM(0);
    if (IN(1)) {
        pg8::Gemm g{XN, Win_t, M, NZ, DM}; pg8::StaticOrder S; S.init(M, NZ, G, bx);
        pg8::EpiZ E{U, CQ, CKV, KR, GA8, GB8, ssq_q, ssq_kv, a.b_gate, cosT, sinT};
        pg8::gemm_phase<pg8::EpiZ, pg8::StaticOrder, true, true>(ring, g, S, E);
    }
    SEAM(1);
    if (IN(2)) {
#if !defined(SUBP) || SUBP==0
        {
            const int w = 2 << (lane >> 4);
            for (int run = gw; run < M / 32; run += NGW) {
                const int r0 = run * 32, s0 = r0 & (SEQ - 1);
                const bf16* up = U + (size_t)r0 * 512 + lane * 8;
                float sum[8] = {0.f, 0.f, 0.f, 0.f, 0.f, 0.f, 0.f, 0.f};
                for (int j = 1; j < 16; ++j) if (j < w && s0 - j >= 0) { const v4u q = *(const v4u*)(up - (size_t)j * 512);
                    sum[0] += bflo(q.x); sum[1] += bfhi(q.x); sum[2] += bflo(q.y); sum[3] += bfhi(q.y); sum[4] += bflo(q.z); sum[5] += bfhi(q.z); sum[6] += bflo(q.w); sum[7] += bfhi(q.w); }
                for (int tb = 0; tb < 32; tb += 4) {
                    v4u q4[4], p4[4];
#pragma unroll
                    for (int j = 0; j < 4; ++j) { q4[j] = *(const v4u*)(up + (size_t)(tb + j) * 512);
                        p4[j] = (s0 + tb + j - (w - 1) >= 0) ? *(const v4u*)(up + (ptrdiff_t)(tb + j - (w - 1)) * 512) : (v4u){0u, 0u, 0u, 0u}; }
                    __builtin_amdgcn_sched_barrier(0);
#pragma unroll
                    for (int j = 0; j < 4; ++j) { const int t = tb + j; const v4u q = q4[j], p = p4[j];
                        const float c[8] = {bflo(q.x), bfhi(q.x), bflo(q.y), bfhi(q.y), bflo(q.z), bfhi(q.z), bflo(q.w), bfhi(q.w)};
                        const int cnt = (s0 + t + 1) < w ? (s0 + t + 1) : w; const float ic = 1.0f / (float)cnt;
                        float o[8];
#pragma unroll
                        for (int k = 0; k < 8; ++k) { sum[k] += c[k]; o[k] = sum[k] * ic - c[k]; }
                        v4u ov; ov.x = pk2(o[0], o[1]); ov.y = pk2(o[2], o[3]); ov.z = pk2(o[4], o[5]); ov.w = pk2(o[6], o[7]);
                        *(v4u*)(POOLED + (size_t)(r0 + t) * 512 + lane * 8) = ov;
                        sum[0] -= bflo(p.x); sum[1] -= bfhi(p.x); sum[2] -= bflo(p.y); sum[3] -= bfhi(p.y); sum[4] -= bflo(p.z); sum[5] -= bfhi(p.z); sum[6] -= bflo(p.w); sum[7] -= bfhi(p.w); }
                }
            }
        }
#endif
#if !defined(SUBP) || SUBP==1
        { pg8::Gemm g{CQ, Wuq_t, M, 1536, 256}; pg8::StaticOrder S; S.init(M, 1536, G, bx);
          pg8::EpiQ E{Qb, ssq_q, cosT, sinT};
          pg8::gemm_phase<pg8::EpiQ, pg8::StaticOrder, true, true>(ring, g, S, E); }
#endif
        {
            const float* ssq = ssq_kv;
            for (int r4 = gw; r4 < M / 4; r4 += NGW) { const int row = r4 * 4 + (lane >> 4), c = (lane & 15) * 8;
                const float rs = 1.0f / sqrtf(ssq[row] * (1.0f / 128.0f) + EPS);
                const v4u q = *(const v4u*)(CKV + (size_t)row * 128 + c);
                v4u o; o.x = pk2(bflo(q.x) * rs, bfhi(q.x) * rs); o.y = pk2(bflo(q.y) * rs, bfhi(q.y) * rs); o.z = pk2(bflo(q.z) * rs, bfhi(q.z) * rs); o.w = pk2(bflo(q.w) * rs, bfhi(q.w) * rs);
                *(v4u*)(LAT + (size_t)row * 128 + c) = o; }
        }
    }
    SEAM(2);
    if (IN(3)) {
        { pg8::Gemm g{POOLED, Wcomb_t, M, DM, 512}; pg8::StaticOrder S; S.init(M, DM, G, bx);
          pg8::EpiStore E{GA};
          pg8::gemm_phase<pg8::EpiStore, pg8::StaticOrder, true, true>(ring, g, S, E); }
        __syncthreads();
#ifdef PROBE_ATT2
        for (int rep_ = 0; rep_ < 2; ++rep_) { __syncthreads();
#endif
        att::attn_phase((char*)lds, Qb, LAT, KR, LAT, Ob, vcu, G, BATCH * att::NH * 8);
#ifdef PROBE_ATT2
        }
#endif
    }
    SEAM(3);
    if (IN(4)) {
        pg8::Gemm g{Ob, Watt_t, M, DM, DM}; pg8::StaticOrder S; S.init(M, DM, G, bx);
        pg8::EpiGate2 E{GA, GA8, GB8};
        pg8::gemm_phase<pg8::EpiGate2, pg8::StaticOrder, true, true>(ring, g, S, E);
    }
    SEAM(4);
    if (IN(5)) {
        pg8::Gemm g{GA, Wout_t, M, DM, DM}; pg8::StaticOrder S; S.init(M, DM, G, bx);
        pg8::EpiRes<true, true> E{XN, X1B, ssq1, nullptr, rms0, a.g_mix};
        pg8::gemm_phase<pg8::EpiRes<true, true>, pg8::StaticOrder, true, true>(ring, g, S, E);
    }
    SEAM(5);
    if (IN(6)) {
        pg8::Gemm g{X1B, W1_t, M, FF, DM}; pg8::StaticOrder S; S.init(M, FF, G, bx);
        pg8::EpiMlpIn E{Hb};
        pg8::gemm_phase<pg8::EpiMlpIn, pg8::StaticOrder, true, true>(ring, g, S, E);
#ifdef PROBE_MLP2
        pg8::gemm_phase<pg8::EpiMlpIn, pg8::StaticOrder, true, true>(ring, g, S, E);
#endif
    }
    SEAM(6);
    if (IN(7)) {
        pg8::Gemm g{Hb, W2_t, M, DM, FF}; pg8::StaticOrder S; S.init(M, DM, G, bx);
        pg8::EpiStore E{X2B};
        pg8::gemm_phase<pg8::EpiStore, pg8::StaticOrder, true, true>(ring, g, S, E);
    }
    SEAM(7);
    if (IN(8)) {
        for (int m = 2 * gw; m < M; m += 2 * NGW) {
            const GAS f32x4* gr = (const GAS f32x4*)a.g_final + 2 * lane; v4u qx[2][2], qd[2][2]; float s1[2];
#pragma unroll
            for (int r = 0; r < 2; ++r) { s1[r] = ssq1[m + r];
#pragma unroll
                for (int j = 0; j < 2; ++j) { qx[r][j] = *(const GAS v4u*)(X1B + (size_t)(m + r) * DM + 8 * lane + 512 * j); qd[r][j] = *(const GAS v4u*)(X2B + (size_t)(m + r) * DM + 8 * lane + 512 * j); } }
#pragma unroll
            for (int r = 0; r < 2; ++r) { const float r2 = 1.0f / (s1[r] * (1.f / DM) + EPS); f32x4 v[2][2]; float s2 = 0.f;
#pragma unroll
                for (int j = 0; j < 2; ++j) { const v4u x = qx[r][j], d = qd[r][j];
                    v[j][0] = (f32x4){bflo(x.x), bfhi(x.x), bflo(x.y), bfhi(x.y)} + (f32x4){bflo(d.x), bfhi(d.x), bflo(d.y), bfhi(d.y)} * r2;
                    v[j][1] = (f32x4){bflo(x.z), bfhi(x.z), bflo(x.w), bfhi(x.w)} + (f32x4){bflo(d.z), bfhi(d.z), bflo(d.w), bfhi(d.w)} * r2;
#pragma unroll
                    for (int h = 0; h < 2; ++h) s2 += (v[j][h].x * v[j][h].x + v[j][h].y * v[j][h].y) + (v[j][h].z * v[j][h].z + v[j][h].w * v[j][h].w); }
                const float rs = 1.0f / sqrtf(wave_sum(s2) * (1.f / DM) + EPS); GAS f32x4* xr = (GAS f32x4*)(a.out + (size_t)(m + r) * DM) + 2 * lane;
#pragma unroll
                for (int j = 0; j < 2; ++j) { xr[128 * j] = v[j][0] * rs * gr[128 * j]; xr[128 * j + 1] = v[j][1] * rs * gr[128 * j + 1]; } }
        }
    }
#undef IN
#undef SEAM
}
#ifdef DEBUG_CHECK
namespace dbg {
__device__ __forceinline__ float bf2f(bf16 v) { return __uint_as_float((unsigned)v << 16); }
__device__ __forceinline__ float rbf(float f) { return __uint_as_float(f2bf(f) << 16); }
__device__ __forceinline__ bool bad(float got, float ref) { return !(fabsf(got - ref) <= 0.03f * fabsf(ref) + 0.03f); }
__device__ __forceinline__ int srow(int s) { const int sp[8] = {0, 1, 255, 256, 4095, 4096, 4097, 65535}; return s < 8 ? (s == 0 ? 0 : s == 1 ? 1 : s == 2 ? 255 : s == 3 ? 256 : s == 4 ? 4095 : s == 5 ? 4096 : s == 6 ? 4097 : 65535) : (int)(((unsigned)s * 2654435761u) >> 16); }
__device__ __forceinline__ void fail(unsigned* flags, int idx) { atomicOr(flags + idx, 1u); }
__device__ float xrstd(const Args& a, int row) { float s = 0.f; for (int k = 0; k < 1024; ++k) { const float v = a.x[(size_t)row * 1024 + k]; s += v * v; } return 1.0f / sqrtf(s / 1024.f + 1e-6f); }
__device__ float zcol(const Args& a, int row, float rstd, int src) { float s = 0.f; for (int k = 0; k < 1024; ++k) s += rbf(a.x[(size_t)row * 1024 + k] * rstd * a.g_mix[k]) * rbf(a.w_in[(size_t)k * 3008 + src]); return s; }
__device__ void cs(const Args& a, int row, int i, float& c, float& s) { const float inv = powf(10000.f, -(float)i / 32.f); const float ang = (float)a.pos[row] * inv; c = cosf(ang); s = sinf(ang); }

__global__ void chk1(Args a) {
    unsigned* flags = (unsigned*)a.ws; unsigned char* ws = a.ws; const int s = blockIdx.x * blockDim.x + threadIdx.x, row = srow(s);
    const bf16 *U = (bf16*)(ws + WS_U), *CQ = (bf16*)(ws + WS_CQ), *CKV = (bf16*)(ws + WS_CKV), *KR = (bf16*)(ws + WS_KR), *GA = (bf16*)(ws + WS_GA), *GB = (bf16*)(ws + WS_GB);
    const float* ssq_q = (const float*)(ws + WS_SSQ); const float* ssq_kv = ssq_q + M;
    const float rstd = xrstd(a, row);
    const int cu = (s * 37) % 512, cq = (s * 29) % 256, ck = (s * 17) % 128, j = (s * 7) % 64, cg = (s * 101) % 1024;
    if (bad(bf2f(U[(size_t)row * 512 + cu]), zcol(a, row, rstd, cu))) fail(flags, 1);
    if (bad(bf2f(CQ[(size_t)row * 256 + cq]), zcol(a, row, rstd, 512 + cq))) fail(flags, 1);
    if (bad(bf2f(CKV[(size_t)row * 128 + ck]), zcol(a, row, rstd, 768 + ck))) fail(flags, 1);
    { const int i = j & 31; float c, sn; cs(a, row, i, c, sn); const float x1 = zcol(a, row, rstd, 896 + i), x2 = zcol(a, row, rstd, 928 + i);
      const float ref = j < 32 ? x1 * c - x2 * sn : x2 * c + x1 * sn; if (bad(bf2f(KR[(size_t)row * 64 + j]), ref)) fail(flags, 2); }
    { const float za = zcol(a, row, rstd, 960 + cg) + a.b_gate[cg], zb = zcol(a, row, rstd, 1984 + cg) + a.b_gate[1024 + cg];
      if (bad(bf2f(GA[(size_t)row * 1024 + cg]), 1.f / (1.f + expf(-za)))) { fail(flags, 3); atomicMax(flags + 32, __float_as_uint(fabsf(bf2f(GA[(size_t)row * 1024 + cg]) - za))); atomicAdd(flags + 33, 1u); }
      if (bad(bf2f(GB[(size_t)row * 1024 + cg]), 1.f / (1.f + expf(-zb)))) fail(flags, 18);
      const bf16* Win_t = (const bf16*)(ws + WS_WIN); const int kk = (s * 3) % 1024, jj = 1024 + cg;
      if (bad(bf2f(Win_t[(size_t)jj * 1024 + kk]) * 100.f, rbf(a.w_in[(size_t)kk * 3008 + jj - 64]) * 100.f)) fail(flags, 17);
      const int j2 = 2048 + cg; if (bad(bf2f(Win_t[(size_t)j2 * 1024 + kk]) * 100.f, rbf(a.w_in[(size_t)kk * 3008 + j2 - 64]) * 100.f)) fail(flags, 19); }
    { float q = 0.f, k = 0.f; for (int c = 0; c < 256; ++c) { const float v = bf2f(CQ[(size_t)row * 256 + c]); q += v * v; } for (int c = 0; c < 128; ++c) { const float v = bf2f(CKV[(size_t)row * 128 + c]); k += v * v; }
      if (bad(ssq_q[row], q) || bad(ssq_kv[row], k)) fail(flags, 4); }
}
__global__ void chk2(Args a) {
    unsigned* flags = (unsigned*)a.ws; unsigned char* ws = a.ws; const int s = blockIdx.x * blockDim.x + threadIdx.x, row = srow(s);
    const bf16 *U = (bf16*)(ws + WS_U), *CQ = (bf16*)(ws + WS_CQ), *CKV = (bf16*)(ws + WS_CKV), *Qb = (bf16*)(ws + WS_Q), *KN = (bf16*)(ws + WS_KN), *Vb = (bf16*)(ws + WS_XN), *POOLED = (bf16*)(ws + WS_POOLED);
    float q = 0.f, k = 0.f; for (int c = 0; c < 256; ++c) { const float v = bf2f(CQ[(size_t)row * 256 + c]); q += v * v; } for (int c = 0; c < 128; ++c) { const float v = bf2f(CKV[(size_t)row * 128 + c]); k += v * v; }
    const float rq = 1.0f / sqrtf(q / 256.f + 1e-6f), rk = 1.0f / sqrtf(k / 128.f + 1e-6f);
    const int h = s & 7, d = (s * 13) % 128, i = (s * 5) % 32;
#define QCOL(col) ({ float acc_ = 0.f; for (int kk = 0; kk < 256; ++kk) acc_ += bf2f(CQ[(size_t)row * 256 + kk]) * rbf(a.g_q[kk] * a.w_uq[(size_t)kk * 1536 + (col)]); acc_ * rq; })
#define KVCOL(col) ({ float acc_ = 0.f; for (int kk = 0; kk < 128; ++kk) acc_ += bf2f(CKV[(size_t)row * 128 + kk]) * rbf(a.g_kv[kk] * a.w_ukv[(size_t)kk * 2048 + (col)]); acc_ * rk; })
    if (bad(bf2f(Qb[(size_t)row * 1536 + h * 192 + d]), QCOL(h * 192 + d))) fail(flags, 5);
    { float c, sn; cs(a, row, i, c, sn); const float x1 = QCOL(h * 192 + 128 + i), x2 = QCOL(h * 192 + 160 + i);
      if (bad(bf2f(Qb[(size_t)row * 1536 + h * 192 + 128 + i]), x1 * c - x2 * sn) || bad(bf2f(Qb[(size_t)row * 1536 + h * 192 + 160 + i]), x2 * c + x1 * sn)) fail(flags, 6); }
    if (bad(bf2f(KN[(size_t)row * 1024 + h * 128 + d]), KVCOL(h * 256 + d)) || bad(bf2f(Vb[(size_t)row * 1024 + h * 128 + d]), KVCOL(h * 256 + 128 + d))) fail(flags, 7);
    { const int c = (s * 37) % 512, w = 2 << (c >> 7), t = row & 4095; float sum = 0.f; int cnt = 0; for (int jj = 0; jj < w; ++jj) if (t - jj >= 0) { sum += bf2f(U[(size_t)(row - jj) * 512 + c]); ++cnt; }
      if (bad(bf2f(POOLED[(size_t)row * 512 + c]), sum / cnt - bf2f(U[(size_t)row * 512 + c]))) fail(flags, 8); }
#undef QCOL
#undef KVCOL
}
__device__ float ya_naive(const Args& a, int row, int col, const bf16* POOLED) {
    const float rstd = xrstd(a, row); const float ga = 1.f / (1.f + expf(-(zcol(a, row, rstd, 960 + col) + a.b_gate[col])));
    float acc = 0.f;
    for (int c = 0; c < 512; ++c) { const int g = c >> 7; float w = 0.f; for (int e = 0; e < 128; ++e) w += a.pool_w[(size_t)c * 128 + e] * a.pool_scale[g * 128 + e] * a.w_pool_proj[(size_t)(g * 128 + e) * 1024 + col]; acc += bf2f(POOLED[(size_t)row * 512 + c]) * rbf(w); }
    return ga * acc;
}
__global__ void chk3(Args a) {
    unsigned* flags = (unsigned*)a.ws; unsigned char* ws = a.ws; const int s = blockIdx.x * blockDim.x + threadIdx.x, row = srow(s);
    const bf16 *Qb = (bf16*)(ws + WS_Q), *KN = (bf16*)(ws + WS_KN), *KR = (bf16*)(ws + WS_KR), *Vb = (bf16*)(ws + WS_XN), *Ob = (bf16*)(ws + WS_O), *POOLED = (bf16*)(ws + WS_POOLED), *GA = (bf16*)(ws + WS_GA);
    const int h = s & 7, d = (s * 13) % 128, t = row & 4095, r0 = row - t;
    float mx = -1e30f;
    for (int key = 0; key <= t; ++key) { float sc = 0.f; for (int e = 0; e < 128; ++e) sc += bf2f(Qb[(size_t)row * 1536 + h * 192 + e]) * bf2f(KN[(size_t)(r0 + key) * 1024 + h * 128 + e]);
        for (int e = 0; e < 64; ++e) sc += bf2f(Qb[(size_t)row * 1536 + h * 192 + 128 + e]) * bf2f(KR[(size_t)(r0 + key) * 64 + e]); sc *= 0.07216878364870322f; mx = fmaxf(mx, sc); }
    float l = 0.f, o = 0.f;
    for (int key = 0; key <= t; ++key) { float sc = 0.f; for (int e = 0; e < 128; ++e) sc += bf2f(Qb[(size_t)row * 1536 + h * 192 + e]) * bf2f(KN[(size_t)(r0 + key) * 1024 + h * 128 + e]);
        for (int e = 0; e < 64; ++e) sc += bf2f(Qb[(size_t)row * 1536 + h * 192 + 128 + e]) * bf2f(KR[(size_t)(r0 + key) * 64 + e]); sc *= 0.07216878364870322f; const float p = expf(sc - mx); l += p; o += p * bf2f(Vb[(size_t)(r0 + key) * 1024 + h * 128 + d]); }
    if (bad(bf2f(Ob[(size_t)row * 1024 + h * 128 + d]), o / l)) fail(flags, 9);
    const int col = (s * 101) % 1024;
    if (bad(bf2f(GA[(size_t)row * 1024 + col]), ya_naive(a, row, col, POOLED))) fail(flags, 10);
}
__global__ void chk4(Args a) {
    unsigned* flags = (unsigned*)a.ws; unsigned char* ws = a.ws; const int s = blockIdx.x * blockDim.x + threadIdx.x, row = srow(s);
    const bf16 *Ob = (bf16*)(ws + WS_O), *POOLED = (bf16*)(ws + WS_POOLED), *GA = (bf16*)(ws + WS_GA);
    const int col = (s * 101) % 1024; const float rstd = xrstd(a, row);
    const float gb = 1.f / (1.f + expf(-(zcol(a, row, rstd, 1984 + col) + a.b_gate[1024 + col])));
    float bm = 0.f; for (int k = 0; k < 1024; ++k) bm += bf2f(Ob[(size_t)row * 1024 + k]) * rbf(a.w_attn[(size_t)k * 1024 + col]);
    if (bad(bf2f(GA[(size_t)row * 1024 + col]), ya_naive(a, row, col, POOLED) + gb * bm)) fail(flags, 11);
}
__global__ void chk5(Args a) {
    unsigned* flags = (unsigned*)a.ws; unsigned char* ws = a.ws; const int s = blockIdx.x * blockDim.x + threadIdx.x, row = srow(s);
    const bf16 *Y = (bf16*)(ws + WS_GA), *X1B = (bf16*)(ws + WS_XN); const float* ssq1 = (const float*)(ws + WS_SSQ) + 2 * M;
    const int col = (s * 101) % 1024;
    float acc = 0.f; for (int k = 0; k < 1024; ++k) acc += bf2f(Y[(size_t)row * 1024 + k]) * rbf(a.w_out[(size_t)k * 1024 + col]);
    const float ref = a.x[(size_t)row * 1024 + col] + acc;
    if (bad(a.out[(size_t)row * 1024 + col], ref) || bad(bf2f(X1B[(size_t)row * 1024 + col]), ref)) fail(flags, 12);
    float q = 0.f; for (int c = 0; c < 1024; ++c) { const float v = a.out[(size_t)row * 1024 + c]; q += v * v; }
    if (bad(ssq1[row], q)) fail(flags, 13);
}
__global__ void chk6(Args a) {
    unsigned* flags = (unsigned*)a.ws; unsigned char* ws = a.ws; const int s = blockIdx.x * blockDim.x + threadIdx.x, row = srow(s);
    const bf16 *X1B = (bf16*)(ws + WS_XN), *Hb = (bf16*)(ws + WS_H); const float* ssq1 = (const float*)(ws + WS_SSQ) + 2 * M;
    const int col = (s * 401) % 4096; const float rs = 1.0f / sqrtf(ssq1[row] / 1024.f + 1e-6f);
    float acc = 0.f; for (int k = 0; k < 1024; ++k) acc += bf2f(X1B[(size_t)row * 1024 + k]) * rbf(a.g_mlp[k] * a.w1[(size_t)k * 4096 + col]);
    const float v = fmaxf(acc * rs, 0.f);
    if (bad(bf2f(Hb[(size_t)row * 4096 + col]), v * v)) fail(flags, 14);
}
__global__ void chk7(Args a) {
    unsigned* flags = (unsigned*)a.ws; unsigned char* ws = a.ws; const int s = blockIdx.x * blockDim.x + threadIdx.x, row = srow(s);
    const bf16 *X1B = (bf16*)(ws + WS_XN), *Hb = (bf16*)(ws + WS_H); const float* ssq2 = (const float*)(ws + WS_SSQ) + 3 * M;
    const int col = (s * 101) % 1024;
    float acc = 0.f; for (int k = 0; k < 4096; ++k) acc += bf2f(Hb[(size_t)row * 4096 + k]) * rbf(a.w2[(size_t)k * 1024 + col]);
    if (bad(a.out[(size_t)row * 1024 + col], bf2f(X1B[(size_t)row * 1024 + col]) + acc)) fail(flags, 15);
    float q = 0.f; for (int c = 0; c < 1024; ++c) { const float v = a.out[(size_t)row * 1024 + c]; q += v * v; }
    if (bad(ssq2[row], q)) fail(flags, 16);
}
__global__ void chk_final(Args a) { const unsigned* flags = (const unsigned*)a.ws; const int order[19] = {17, 19, 1, 2, 3, 18, 4, 5, 6, 7, 8, 9, 10, 11, 12, 13, 14, 15, 16}; int first = 0; for (int i = 0; i < 19; ++i) if (flags[order[i]] && !first) first = order[i]; if (first) a.out[0] += 1000.f * first; a.out[1] += 1e6f * __uint_as_float(flags[32]); }
}
#endif
constexpr int N_PHASES = 9;

extern "C" void kernel_launch(void* const* d_in, const int* in_sizes, int n_in, void* d_out, int out_size, void* d_ws, size_t ws_size, hipStream_t stream) {
    static int grid = 0;
    if (grid == 0) {
        if (n_in != 18 || in_sizes[0] != M * DM || out_size != M * DM || ws_size < WS_END) { fprintf(stderr, "kernel_launch: unexpected shapes (n_in %d, in0 %d, out %d, ws %zu)\n", n_in, n_in > 0 ? in_sizes[0] : -1, out_size, ws_size); grid = -1; return; }
        int dev = 0, cus = 0, per_cu = 0;
        if (hipGetDevice(&dev) != hipSuccess || hipDeviceGetAttribute(&cus, hipDeviceAttributeMultiprocessorCount, dev) != hipSuccess) { grid = -1; return; }
        if (hipFuncSetAttribute((const void*)mk_fwd, hipFuncAttributeMaxDynamicSharedMemorySize, LDS_BYTES) != hipSuccess) { fprintf(stderr, "kernel_launch: hipFuncSetAttribute failed\n"); grid = -1; return; }
        if (hipOccupancyMaxActiveBlocksPerMultiprocessor(&per_cu, (const void*)mk_fwd, NWAVES * 64, LDS_BYTES) != hipSuccess || per_cu < 1) { fprintf(stderr, "kernel_launch: occupancy query says %d\n", per_cu); per_cu = 1; }
        (void)hipGetLastError();
        grid = cus * (per_cu > 1 ? 1 : per_cu);
    }
    if (grid < 0) return;
#ifdef DEBUG_CHECK
    (void)hipMemsetAsync((char*)d_ws, 0, 4096, stream);
    (void)hipMemsetAsync((char*)d_ws + WS_GA, 0x40, 128 * MiB, stream);
#endif
    (void)hipMemsetAsync((char*)d_ws, 0, WS_SSQ + (size_t)4 * M * sizeof(float), stream);
    Args a{};
    a.x = (const float*)d_in[0]; a.pos = (const int*)d_in[1]; a.g_mix = (const float*)d_in[2]; a.w_in = (const float*)d_in[3]; a.b_gate = (const float*)d_in[4];
    a.pool_w = (const float*)d_in[5]; a.pool_scale = (const float*)d_in[6]; a.w_pool_proj = (const float*)d_in[7]; a.g_q = (const float*)d_in[8]; a.w_uq = (const float*)d_in[9];
    a.g_kv = (const float*)d_in[10]; a.w_ukv = (const float*)d_in[11]; a.w_attn = (const float*)d_in[12]; a.w_out = (const float*)d_in[13]; a.g_mlp = (const float*)d_in[14];
    a.w1 = (const float*)d_in[15]; a.w2 = (const float*)d_in[16]; a.g_final = (const float*)d_in[17];
    a.out = (float*)d_out; a.ws = (unsigned char*)d_ws;
#if MK_LAUNCHES == 1
    a.ph_lo = 0; a.ph_hi = N_PHASES;
    void* args[] = {&a};
    hipError_t e = hipLaunchCooperativeKernel((const void*)mk_fwd, dim3(grid), dim3(NWAVES * 64), args, LDS_BYTES, stream);
    if (e != hipSuccess) fprintf(stderr, "kernel_launch: cooperative launch failed: %s (grid %d)\n", hipGetErrorString(e), grid);
#else
    for (int p = 0; p < N_PHASES; ++p) { a.ph_lo = p; a.ph_hi = p + 1; hipLaunchKernelGGL(mk_fwd, dim3(grid), dim3(NWAVES * 64), LDS_BYTES, stream, a);
#ifdef DEBUG_CHECK
        if (p == 1) hipLaunchKernelGGL(dbg::chk1, dim3(1), dim3(64), 0, stream, a);
        if (p == 2) hipLaunchKernelGGL(dbg::chk2, dim3(1), dim3(64), 0, stream, a);
        if (p == 3) hipLaunchKernelGGL(dbg::chk3, dim3(1), dim3(64), 0, stream, a);
        if (p == 4) hipLaunchKernelGGL(dbg::chk4, dim3(1), dim3(64), 0, stream, a);
        if (p == 5) hipLaunchKernelGGL(dbg::chk5, dim3(1), dim3(64), 0, stream, a);
        if (p == 6) hipLaunchKernelGGL(dbg::chk6, dim3(1), dim3(64), 0, stream, a);
        if (p == 7) hipLaunchKernelGGL(dbg::chk7, dim3(1), dim3(64), 0, stream, a);
        if (p == 8) hipLaunchKernelGGL(dbg::chk_final, dim3(1), dim3(1), 0, stream, a);
#endif
    }
#endif
}
```
